# Optimizing an MI355X kernel written in HIP

```python
import jax, jax.numpy as jnp
from jax import lax
import numpy as np

D_MODEL = 2048
BATCH = 1
SEQ = 8192
DEPTH = 1

HEAD_DIM = 128
N_SPARSE_HEADS = 8
SPARSE_WIDTH = N_SPARSE_HEADS * HEAD_DIM
N_IDX_HEADS = 16
IDX_HEAD_DIM = 64
TOPK_MAX = 256
DIL_GROUPS = ((128, 1), (512, 4), (2048, 16))
HEADS_PER_DIL_GROUP = 4
N_DIL_HEADS = HEADS_PER_DIL_GROUP * len(DIL_GROUPS)
DIL_WIDTH = N_DIL_HEADS * HEAD_DIM
DIL_OUT_WIDTH = HEADS_PER_DIL_GROUP * HEAD_DIM
N_ALIBI_HEADS = N_DIL_HEADS + N_SPARSE_HEADS
BLOCK = 128
D_FF = ((-(-8 * D_MODEL // 3)) + 255) // 256 * 256
DEEPNORM_ALPHA = (2 * DEPTH) ** 0.25
DEEPNORM_BETA = (8 * DEPTH) ** -0.25
LN_EPS = 1e-5
IN_SIZES = (SPARSE_WIDTH, SPARSE_WIDTH, SPARSE_WIDTH,
            N_IDX_HEADS * IDX_HEAD_DIM, IDX_HEAD_DIM, N_IDX_HEADS,
            DIL_WIDTH, DIL_WIDTH, DIL_WIDTH,
            D_MODEL, D_MODEL)
IN_WIDTH = sum(IN_SIZES)
V_COLUMN_SLOTS = (2, 8)

kernel_name = "hybrid_dsa_dilated_gated_deepnorm"


def layer_norm(x, g, b):
    xf = x.astype(jnp.float32)
    mu = jnp.mean(xf, -1, keepdims=True)
    var = jnp.mean(jnp.square(xf - mu), -1, keepdims=True)
    y = (xf - mu) * lax.rsqrt(var + LN_EPS) * g.astype(jnp.float32) + b.astype(jnp.float32)
    return y.astype(x.dtype)


def alibi_slopes():
    return jnp.exp2(-8.0 * jnp.arange(1, N_ALIBI_HEADS + 1, dtype=jnp.float32) / N_ALIBI_HEADS)


def dsa_attention(q, k, v, q_idx, k_idx, w_idx, slopes):
    B, S, H, Dh = q.shape
    topk = min(TOPK_MAX, S // 4)
    nb = S // BLOCK
    key_pos = jnp.arange(S)
    k_idx32 = k_idx.astype(jnp.float32)
    gather = jax.vmap(lambda a, i: a[i])

    def to_blocks(a):
        return jnp.moveaxis(a.reshape((B, nb, BLOCK) + a.shape[2:]), 1, 0)

    def block_fn(args):
        n, qb, qib, wb = args
        qpos = n * BLOCK + jnp.arange(BLOCK)
        rel = jnp.einsum('bqhd,bsd->bqhs', qib.astype(jnp.float32), k_idx32) * IDX_HEAD_DIM ** -0.5
        score = jnp.einsum('bqh,bqhs->bqs', wb.astype(jnp.float32), jax.nn.relu(rel))
        causal = key_pos[None, :] <= qpos[:, None]
        score = jnp.where(causal[None], score, -jnp.inf)
        _, sel = lax.top_k(score, topk)
        ks = gather(k, sel)
        vs = gather(v, sel)
        logits = jnp.einsum('bqhd,bqkhd->bhqk', qb, ks,
                            preferred_element_type=jnp.float32) * Dh ** -0.5
        dist = (qpos[None, :, None] - sel).astype(jnp.float32)
        logits = logits - slopes[None, :, None, None] * dist[:, None]
        valid = sel <= qpos[None, :, None]
        logits = jnp.where(valid[:, None], logits, -jnp.inf)
        p = jax.nn.softmax(logits, axis=-1).astype(v.dtype)
        return jnp.einsum('bhqk,bqkhd->bqhd', p, vs)

    out = lax.map(block_fn, (jnp.arange(nb), to_blocks(q), to_blocks(q_idx), to_blocks(w_idx)))
    return jnp.moveaxis(out, 0, 1).reshape(B, S, H * Dh)


def dilated_group_attention(q, k, v, window, dilation, slopes):
    B, S, h, Dh = q.shape
    span = window // dilation
    assert span <= BLOCK
    n_sub = -(-S // dilation)
    n_pad = -(-n_sub // BLOCK) * BLOCK
    s_pad = n_pad * dilation
    nb = n_pad // BLOCK

    def to_sub(a):
        a = jnp.pad(a, ((0, 0), (0, s_pad - S), (0, 0), (0, 0)))
        a = a.reshape(B, n_pad, dilation, h, Dh).transpose(0, 2, 1, 3, 4)
        return a.reshape(B * dilation, nb, BLOCK, h, Dh)

    def prev(a):
        return jnp.pad(a, ((0, 0), (1, 0), (0, 0), (0, 0), (0, 0)))[:, :-1]

    qs, ks, vs = to_sub(q), to_sub(k), to_sub(v)
    kk = jnp.concatenate([prev(ks), ks], axis=2)
    vv = jnp.concatenate([prev(vs), vs], axis=2)
    logits = jnp.einsum('znqhd,znkhd->zhnqk', qs, kk,
                        preferred_element_type=jnp.float32) * Dh ** -0.5
    step = BLOCK + jnp.arange(BLOCK)[:, None] - jnp.arange(2 * BLOCK)[None, :]
    key_sub = jnp.arange(nb)[:, None] * BLOCK - BLOCK + jnp.arange(2 * BLOCK)[None, :]
    mask = ((step >= 0) & (step <= span))[None] & (key_sub >= 0)[:, None, :]
    logits = logits - slopes[None, :, None, None, None] * (step * dilation).astype(jnp.float32)
    logits = jnp.where(mask[None, None], logits, -jnp.inf)
    lse = jax.nn.logsumexp(logits, axis=-1)
    p = jnp.exp(logits - lse[..., None]).astype(v.dtype)
    o = jnp.einsum('zhnqk,znkhd->znqhd', p, vv)

    def from_sub(a):
        tail = a.shape[4:]
        a = a.reshape((B, dilation, n_pad, h) + tail)
        a = jnp.swapaxes(a, 1, 2).reshape((B, s_pad, h) + tail)
        return a[:, :S]

    return from_sub(o), from_sub(jnp.moveaxis(lse, 1, -1))


def hybrid_mixer(x, w_in, w_a, w_b, w_out, slopes):
    B, S, _ = x.shape
    split_points = [int(c) for c in np.cumsum(IN_SIZES)[:-1]]
    proj = x @ w_in
    aq, ak, av, iq, ik, iw, bq, bk, bv, ga, gb = jnp.split(proj, split_points, axis=-1)

    def heads(a, n):
        return a.reshape(B, S, n, -1)

    o_a = dsa_attention(heads(aq, N_SPARSE_HEADS), heads(ak, N_SPARSE_HEADS), heads(av, N_SPARSE_HEADS),
                        heads(iq, N_IDX_HEADS), ik, iw * N_IDX_HEADS ** -0.5,
                        slopes[N_DIL_HEADS:])

    bq4, bk4, bv4 = heads(bq, N_DIL_HEADS), heads(bk, N_DIL_HEADS), heads(bv, N_DIL_HEADS)
    outs, lses = [], []
    for g, (win, dil) in enumerate(DIL_GROUPS):
        sl = slice(g * HEADS_PER_DIL_GROUP, (g + 1) * HEADS_PER_DIL_GROUP)
        o_g, l_g = dilated_group_attention(bq4[:, :, sl], bk4[:, :, sl], bv4[:, :, sl], win, dil, slopes[sl])
        outs.append(o_g)
        lses.append(l_g)
    wts = jax.nn.softmax(jnp.stack(lses), axis=0).astype(x.dtype)
    o_b = jnp.einsum('gbsh,gbshd->bshd', wts, jnp.stack(outs)).reshape(B, S, DIL_OUT_WIDTH)

    merged = jax.nn.sigmoid(ga) * (o_a @ w_a) + jax.nn.sigmoid(gb) * (o_b @ w_b)
    return merged @ w_out


def swiglu_ffn(h, w_gate, w_up, w_down):
    return (jax.nn.silu(h @ w_gate) * (h @ w_up)) @ w_down


def setup_inputs(seed: int = 0) -> dict:
    key = jax.random.key(seed)
    ks = jax.random.split(key, 12)
    f32 = jnp.float32
    x = jax.random.normal(ks[0], (BATCH, SEQ, D_MODEL), f32)
    col_scale = jnp.concatenate([
        jnp.full((n,), DEEPNORM_BETA if i in V_COLUMN_SLOTS else 1.0, f32)
        for i, n in enumerate(IN_SIZES)])
    w_in = jax.random.normal(ks[1], (DEPTH, D_MODEL, IN_WIDTH), f32) * (D_MODEL ** -0.5) * col_scale
    w_a = jax.random.normal(ks[2], (DEPTH, SPARSE_WIDTH, D_MODEL), f32) * (SPARSE_WIDTH ** -0.5 * DEEPNORM_BETA)
    w_b = jax.random.normal(ks[3], (DEPTH, DIL_OUT_WIDTH, D_MODEL), f32) * (DIL_OUT_WIDTH ** -0.5 * DEEPNORM_BETA)
    w_out = jax.random.normal(ks[4], (DEPTH, D_MODEL, D_MODEL), f32) * (D_MODEL ** -0.5 * DEEPNORM_BETA)
    ln1_g = 1.0 + 0.01 * jax.random.normal(ks[5], (DEPTH, D_MODEL), f32)
    ln1_b = 0.01 * jax.random.normal(ks[6], (DEPTH, D_MODEL), f32)
    w_gate = jax.random.normal(ks[7], (DEPTH, D_MODEL, D_FF), f32) * (D_MODEL ** -0.5)
    w_up = jax.random.normal(ks[8], (DEPTH, D_MODEL, D_FF), f32) * (D_MODEL ** -0.5 * DEEPNORM_BETA)
    w_down = jax.random.normal(ks[9], (DEPTH, D_FF, D_MODEL), f32) * (D_FF ** -0.5 * DEEPNORM_BETA)
    ln2_g = 1.0 + 0.01 * jax.random.normal(ks[10], (DEPTH, D_MODEL), f32)
    ln2_b = 0.01 * jax.random.normal(ks[11], (DEPTH, D_MODEL), f32)
    return {"x": x, "w_in": w_in, "w_a": w_a, "w_b": w_b, "w_out": w_out,
            "ln1_g": ln1_g, "ln1_b": ln1_b, "w_gate": w_gate, "w_up": w_up,
            "w_down": w_down, "ln2_g": ln2_g, "ln2_b": ln2_b}


def reference(x, w_in, w_a, w_b, w_out, ln1_g, ln1_b, w_gate, w_up, w_down, ln2_g, ln2_b):
    slopes = alibi_slopes()
    for l in range(DEPTH):
        h = layer_norm(DEEPNORM_ALPHA * x + hybrid_mixer(x, w_in[l], w_a[l], w_b[l], w_out[l], slopes),
                       ln1_g[l], ln1_b[l])
        x = layer_norm(DEEPNORM_ALPHA * h + swiglu_ffn(h, w_gate[l], w_up[l], w_down[l]),
                       ln2_g[l], ln2_b[l])
    return x
```

```cpp
#include <hip/hip_runtime.h>
#include <cstdio>
#include <cstdint>
namespace pg8 {
#define PG8_LAS __attribute__((address_space(3)))
typedef unsigned short bf16_t;
typedef short bf16x8 __attribute__((ext_vector_type(8)));
typedef float f32x4 __attribute__((ext_vector_type(4)));
typedef unsigned u32x4 __attribute__((ext_vector_type(4)));
constexpr int BM = 256, BK = 64, HALF = 128, HTB = HALF * BK * 2  , STAGE_BYTES = 8 * HTB, NXCD = 8, WGM = 8;

__host__ __device__ __forceinline__ int lds_byte(int r, int c) { const int st = (r >> 4) * 2 + (c >> 5), rr = r & 15, cc = c & 31, ob = rr * 64 + cc * 2; return st * 1024 + (ob ^ (((ob >> 9) & 1) << 5)); }
__host__ __device__ __forceinline__ void stage_rc(int b, int& R, int& C) { const int st = b / 1024, sb = b % 1024, swz = sb ^ (((sb >> 9) & 1) << 5); R = (st >> 1) * 16 + swz / 64; C = (st & 1) * 32 + (swz % 64) / 2; }
__host__ __device__ __forceinline__ int perm32(int rho) { const int n = rho >> 4, i = rho & 15; return 8 * (i >> 2) + 4 * n + (i & 3); }

struct Unit { int pm, pn; };
struct Gemm { const bf16_t* A; const bf16_t* Bt; int M, N, K; };

struct StaticOrder {
    int nM, nN, nwg, G, c;
    __host__ __device__ void init(int M, int N, int G_, int c_) { nM = M / BM; nN = N / BM; nwg = nM * nN; G = G_; c = c_; }
    __host__ __device__ bool next(int i, Unit& u) const {
        const long L = (long)i * G + c; if (L >= nwg) return false;
        int wgid = (int)L; { const int q = nwg / NXCD, r = nwg % NXCD, xcd = wgid % NXCD, off = wgid / NXCD; wgid = (xcd < r ? xcd * (q + 1) : r * (q + 1) + (xcd - r) * q) + off; }
        const int nig = WGM * nN, gid = wgid / nig, fm = gid * WGM, gsz = (nM - fm) < WGM ? (nM - fm) : WGM;
        u.pm = fm + ((wgid % nig) % gsz); u.pn = (wgid % nig) / gsz; return true;
    }
    __device__ __forceinline__ void a_ready(const Unit&) const {}
    __device__ __forceinline__ void done(const Unit&) const {}
};

__device__ __forceinline__ unsigned cvt_pk_bf16(float lo, float hi) { unsigned r; asm volatile("v_cvt_pk_bf16_f32 %0, %1, %2" : "=v"(r) : "v"(lo), "v"(hi)); return r; }
__device__ __forceinline__ float bf_lo(unsigned w) { return __uint_as_float(w << 16); }
__device__ __forceinline__ float bf_hi(unsigned w) { return __uint_as_float(w & 0xffff0000u); }
__device__ __forceinline__ float sigmoidf_fast(float v) { return __builtin_amdgcn_rcpf(1.0f + __builtin_amdgcn_exp2f(-1.4426950408889634f * v)); }

struct EpiProj {
    static constexpr bool PERM = true, AFTER_DRAIN = false;
    bf16_t* O; int ldc; int sig_lo, sig_hi;
    __device__ __forceinline__ void operator()(const f32x4 (&acc)[2][2][4][2], const Unit& u, int wr, int wc, int fr, int fq) const {
        const int row0 = u.pm * BM + wr * 64 + fr; const int colt = u.pn * BM; const bool sg = colt >= sig_lo && colt < sig_hi;
        const int col0 = colt + wc * 32 + 8 * fq;
#pragma unroll
        for (int ai = 0; ai < 2; ++ai)
#pragma unroll
            for (int m = 0; m < 4; ++m) { bf16_t* rowp = O + (size_t)(row0 + ai * HALF + m * 16) * ldc + col0;
#pragma unroll
                for (int bj = 0; bj < 2; ++bj) { f32x4 v0 = acc[ai][bj][m][0], v1 = acc[ai][bj][m][1];
                    if (sg) {
#pragma unroll
                        for (int e = 0; e < 4; ++e) { v0[e] = sigmoidf_fast(v0[e]); v1[e] = sigmoidf_fast(v1[e]); } }
                    u32x4 w; w.x = cvt_pk_bf16(v0[0], v0[1]); w.y = cvt_pk_bf16(v0[2], v0[3]); w.z = cvt_pk_bf16(v1[0], v1[1]); w.w = cvt_pk_bf16(v1[2], v1[3]);
                    *(u32x4*)(rowp + bj * HALF) = w; } }
    }
};
template <int PART> struct EpiMerge {
    static constexpr bool PERM = true, AFTER_DRAIN = false;
    const bf16_t* G; int ldg; int gcol; float* T; int ldt; bf16_t* O; int ldo;
    __device__ __forceinline__ void operator()(const f32x4 (&acc)[2][2][4][2], const Unit& u, int wr, int wc, int fr, int fq) const {
        const int row0 = u.pm * BM + wr * 64 + fr; const int col0 = u.pn * BM + wc * 32 + 8 * fq;
#pragma unroll
        for (int ai = 0; ai < 2; ++ai)
#pragma unroll
            for (int m = 0; m < 4; ++m) { const size_t row = (size_t)(row0 + ai * HALF + m * 16);
#pragma unroll
                for (int bj = 0; bj < 2; ++bj) { const int col = col0 + bj * HALF;
                    const u32x4 gw = *(const u32x4*)(G + row * ldg + gcol + col);
                    f32x4 g0 = {bf_lo(gw.x), bf_hi(gw.x), bf_lo(gw.y), bf_hi(gw.y)}, g1 = {bf_lo(gw.z), bf_hi(gw.z), bf_lo(gw.w), bf_hi(gw.w)};
                    f32x4 v0 = acc[ai][bj][m][0] * g0, v1 = acc[ai][bj][m][1] * g1;
                    float* tp = T + row * ldt + col;
                    if (PART == 1) { *(f32x4*)tp = v0; *(f32x4*)(tp + 4) = v1; }
                    else { v0 = v0 + *(const f32x4*)tp; v1 = v1 + *(const f32x4*)(tp + 4);
                        u32x4 w; w.x = cvt_pk_bf16(v0[0], v0[1]); w.y = cvt_pk_bf16(v0[2], v0[3]); w.z = cvt_pk_bf16(v1[0], v1[1]); w.w = cvt_pk_bf16(v1[2], v1[3]);
                        *(u32x4*)(O + row * ldo + col) = w; } } }
    }
};
struct EpiRes {
    static constexpr bool PERM = false, AFTER_DRAIN = false;
    const float* R; float* Y; int ldc; float alpha;
    __device__ __forceinline__ void operator()(const f32x4 (&acc)[2][2][4][2], const Unit& u, int wr, int wc, int fr, int fq) const {
        const int row0 = u.pm * BM + wr * 64 + fr, col0 = u.pn * BM + wc * 32 + 4 * fq;
#pragma unroll
        for (int ai = 0; ai < 2; ++ai)
#pragma unroll
            for (int m = 0; m < 4; ++m) { const size_t off = (size_t)(row0 + ai * HALF + m * 16) * ldc + col0;
#pragma unroll
                for (int bj = 0; bj < 2; ++bj)
#pragma unroll
                    for (int n = 0; n < 2; ++n) { const f32x4 r = *(const f32x4*)(R + off + bj * HALF + n * 16); *(f32x4*)(Y + off + bj * HALF + n * 16) = r * alpha + acc[ai][bj][m][n]; } }
    }
};
struct EpiSwiGLU {
    static constexpr bool PERM = true, AFTER_DRAIN = false;
    bf16_t* O; int ldc;
    __device__ __forceinline__ void operator()(const f32x4 (&acc)[2][2][4][2], const Unit& u, int wr, int wc, int fr, int fq) const {
        const int row0 = u.pm * BM + wr * 64 + fr; const int col0 = u.pn * HALF + wc * 32 + 8 * fq;
#pragma unroll
        for (int ai = 0; ai < 2; ++ai)
#pragma unroll
            for (int m = 0; m < 4; ++m) { f32x4 g0 = acc[ai][0][m][0], g1 = acc[ai][0][m][1]; const f32x4 u0 = acc[ai][1][m][0], u1 = acc[ai][1][m][1];
#pragma unroll
                for (int e = 0; e < 4; ++e) { g0[e] = g0[e] * sigmoidf_fast(g0[e]) * u0[e]; g1[e] = g1[e] * sigmoidf_fast(g1[e]) * u1[e]; }
                u32x4 w; w.x = cvt_pk_bf16(g0[0], g0[1]); w.y = cvt_pk_bf16(g0[2], g0[3]); w.z = cvt_pk_bf16(g1[0], g1[1]); w.w = cvt_pk_bf16(g1[2], g1[3]);
                *(u32x4*)(O + (size_t)(row0 + ai * HALF + m * 16) * ldc + col0) = w; }
    }
};

template <class Epi, class Sched, bool ALIGN_EPI = false, bool SP2 = false>
__device__ __forceinline__ void gemm_phase(PG8_LAS unsigned char* lds, const Gemm g, const Sched& S, const Epi& E) {
    const int tid = threadIdx.x, wid = __builtin_amdgcn_readfirstlane(tid >> 6), lane = tid & 63, wr = wid >> 2, wc = wid & 3, fr = lane & 15, fq = lane >> 4;
    const int K = g.K, nt = K / BK;
    unsigned voffA[2], voffB[2];
#pragma unroll
    for (int i = 0; i < 2; ++i) { int R, C; stage_rc(tid * 16 + i * 8192, R, C); const int Rb = Epi::PERM ? ((R & ~31) + perm32(R & 31)) : R;
        voffA[i] = (unsigned)(R * K + C) * 2u; voffB[i] = (unsigned)(Rb * K + C) * 2u; }
    const size_t kstep = (size_t)(BK * 2);
    const size_t hstep = (size_t)HALF * K * 2;
    const size_t tstep = 2 * hstep;
    const unsigned ldsw = (unsigned)wid * 1024u;
    const int aoff = lds_byte(wr * 64 + fr, fq * 8), boff = lds_byte(wc * 32 + fr, fq * 8);
#define PG8_SA(b, h) (((b) * 2 + (h)) * HTB)
#define PG8_SB(b, h) ((4 + (b) * 2 + (h)) * HTB)
#define PG8_STAGE(bufoff, gbase, voff) do { _Pragma("unroll") for (int _i = 0; _i < 2; ++_i) \
        __builtin_amdgcn_global_load_lds((const unsigned*)((const char*)(gbase) + (voff)[_i]), (PG8_LAS unsigned*)(lds + (bufoff) + ldsw + _i * 8192), 16, 0, 0); } while (0)
#define PG8_LDA(dst, b, h) do { _Pragma("unroll") for (int m = 0; m < 4; ++m) _Pragma("unroll") for (int k = 0; k < 2; ++k) dst[m][k] = *(const PG8_LAS bf16x8*)(lds + PG8_SA(b, h) + aoff + m * 2048 + k * 1024); } while (0)
#define PG8_LDB(dst, b, h) do { _Pragma("unroll") for (int n = 0; n < 2; ++n) _Pragma("unroll") for (int k = 0; k < 2; ++k) dst[n][k] = *(const PG8_LAS bf16x8*)(lds + PG8_SB(b, h) + boff + n * 2048 + k * 1024); } while (0)
#define PG8_MMA(ai, bj, At, Bt) do { __builtin_amdgcn_s_setprio(1); _Pragma("unroll") for (int m = 0; m < 4; ++m) _Pragma("unroll") for (int n = 0; n < 2; ++n) _Pragma("unroll") for (int k = 0; k < 2; ++k) \
        acc[ai][bj][m][n] = __builtin_amdgcn_mfma_f32_16x16x32_bf16(Bt[n][k], At[m][k], acc[ai][bj][m][n], 0, 0, 0); __builtin_amdgcn_s_setprio(0); } while (0)
#define PG8_WAIT_V(n) asm volatile("s_waitcnt vmcnt(" #n ")" ::: "memory")
#define PG8_WAIT_L(n) asm volatile("s_waitcnt lgkmcnt(" #n ")" ::: "memory")
#define PG8_BAR __builtin_amdgcn_s_barrier()
#define PG8_SCHED __builtin_amdgcn_sched_barrier(0)
    Unit cur, nxt; int ui = 0;
    if (!S.next(0, cur)) return;
    f32x4 acc[2][2][4][2];
#pragma unroll
    for (int a = 0; a < 2; ++a)
#pragma unroll
        for (int b = 0; b < 2; ++b)
#pragma unroll
            for (int m = 0; m < 4; ++m)
#pragma unroll
                for (int n = 0; n < 2; ++n) acc[a][b][m][n] = (f32x4){0.f, 0.f, 0.f, 0.f};
    bf16x8 At[4][2], B0[2][2], B1[2][2];
    const char* cA = (const char*)g.A + (size_t)cur.pm * tstep; const char* cB = (const char*)g.Bt + (size_t)cur.pn * tstep;
    S.a_ready(cur);
    if constexpr (SP2) {
        PG8_STAGE(PG8_SB(0, 0), cB, voffB); PG8_STAGE(PG8_SB(0, 1), cB + hstep, voffB); PG8_STAGE(PG8_SA(0, 0), cA, voffA); PG8_STAGE(PG8_SA(0, 1), cA + hstep, voffA);
        if (wr == 1) PG8_BAR;
        PG8_WAIT_V(2); PG8_BAR;
        PG8_STAGE(PG8_SB(1, 0), cB + kstep, voffB); PG8_STAGE(PG8_SA(1, 0), cA + kstep, voffA); PG8_STAGE(PG8_SB(1, 1), cB + hstep + kstep, voffB);
        PG8_WAIT_V(6); PG8_BAR;
    } else {
        PG8_STAGE(PG8_SB(0, 0), cB, voffB); PG8_STAGE(PG8_SA(0, 0), cA, voffA); PG8_STAGE(PG8_SB(0, 1), cB + hstep, voffB); PG8_STAGE(PG8_SA(0, 1), cA + hstep, voffA);
        if (wr == 1) PG8_BAR;
        PG8_WAIT_V(4); PG8_BAR;
        PG8_STAGE(PG8_SB(1, 0), cB + kstep, voffB); PG8_STAGE(PG8_SA(1, 0), cA + kstep, voffA); PG8_STAGE(PG8_SB(1, 1), cB + hstep + kstep, voffB);
        PG8_WAIT_V(6); PG8_BAR;
    }
    for (;;) {
        const bool has_next = S.next(ui + 1, nxt);
        const char* nA = has_next ? (const char*)g.A + (size_t)nxt.pm * tstep : cA; const char* nB = has_next ? (const char*)g.Bt + (size_t)nxt.pn * tstep : cB;
        for (int t = 0; t < nt; t += 2) {
            const bool last = (t == nt - 2);
            const char* a1 = cA + (size_t)(t + 1) * kstep;
            const char* a2 = last ? nA : cA + (size_t)(t + 2) * kstep; const char* b2 = last ? nB : cB + (size_t)(t + 2) * kstep;
            const char* a3 = a2 + kstep; const char* b3 = b2 + kstep;
            if (last && has_next) S.a_ready(nxt);
            if constexpr (SP2) {
            PG8_LDB(B0, 0, 0); PG8_LDB(B1, 0, 1); PG8_SCHED; PG8_LDA(At, 0, 0); PG8_STAGE(PG8_SA(1, 1), a1 + hstep, voffA);
            PG8_WAIT_V(8); PG8_WAIT_L(0); PG8_BAR; PG8_MMA(0, 0, At, B0); PG8_MMA(0, 1, At, B1); PG8_BAR; PG8_SCHED;
            PG8_LDA(At, 0, 1); PG8_STAGE(PG8_SB(0, 0), b2, voffB); PG8_STAGE(PG8_SB(0, 1), b2 + hstep, voffB); PG8_STAGE(PG8_SA(0, 0), a2, voffA);
            PG8_WAIT_V(8); PG8_WAIT_L(0); PG8_BAR; PG8_MMA(1, 0, At, B0); PG8_MMA(1, 1, At, B1); PG8_BAR; PG8_SCHED;
            PG8_LDB(B0, 1, 0); PG8_LDB(B1, 1, 1); PG8_SCHED; PG8_LDA(At, 1, 0); PG8_STAGE(PG8_SA(0, 1), a2 + hstep, voffA);
            PG8_WAIT_V(8); PG8_WAIT_L(0); PG8_BAR; PG8_MMA(0, 0, At, B0); PG8_MMA(0, 1, At, B1); PG8_BAR; PG8_SCHED;
            PG8_LDA(At, 1, 1); PG8_STAGE(PG8_SB(1, 0), b3, voffB); PG8_STAGE(PG8_SB(1, 1), b3 + hstep, voffB); PG8_STAGE(PG8_SA(1, 0), a3, voffA);
            PG8_WAIT_V(8); PG8_WAIT_L(0); PG8_BAR; PG8_MMA(1, 0, At, B0); PG8_MMA(1, 1, At, B1); PG8_BAR; PG8_SCHED;
            } else {
            PG8_LDB(B0, 0, 0); PG8_SCHED; PG8_LDA(At, 0, 0); PG8_STAGE(PG8_SA(1, 1), a1 + hstep, voffA);
            PG8_WAIT_L(8); PG8_BAR; PG8_WAIT_L(0); PG8_MMA(0, 0, At, B0); PG8_BAR; PG8_SCHED;
            PG8_LDB(B1, 0, 1); PG8_STAGE(PG8_SB(0, 0), b2, voffB);
            PG8_BAR; PG8_WAIT_L(0); PG8_MMA(0, 1, At, B1); PG8_BAR;
            PG8_LDA(At, 0, 1); PG8_STAGE(PG8_SA(0, 0), a2, voffA);
            PG8_BAR; PG8_WAIT_L(0); PG8_MMA(1, 0, At, B0); PG8_BAR; PG8_SCHED;
            PG8_STAGE(PG8_SB(0, 1), b2 + hstep, voffB);
            PG8_WAIT_V(6); PG8_BAR; PG8_MMA(1, 1, At, B1); PG8_BAR;
            PG8_LDB(B0, 1, 0); PG8_SCHED; PG8_LDA(At, 1, 0); PG8_STAGE(PG8_SA(0, 1), a2 + hstep, voffA);
            PG8_WAIT_L(8); PG8_BAR; PG8_WAIT_L(0); PG8_MMA(0, 0, At, B0); PG8_BAR; PG8_SCHED;
            PG8_LDB(B1, 1, 1); PG8_STAGE(PG8_SB(1, 0), b3, voffB);
            PG8_BAR; PG8_WAIT_L(0); PG8_MMA(0, 1, At, B1); PG8_BAR;
            PG8_LDA(At, 1, 1); PG8_STAGE(PG8_SA(1, 0), a3, voffA);
            PG8_BAR; PG8_WAIT_L(0); PG8_MMA(1, 0, At, B0); PG8_BAR; PG8_SCHED;
            PG8_STAGE(PG8_SB(1, 1), b3 + hstep, voffB);
            PG8_WAIT_V(6); PG8_BAR; PG8_MMA(1, 1, At, B1); PG8_BAR;
            }
        }
        if constexpr (ALIGN_EPI) { if (wr == 0) PG8_BAR; }
        if constexpr (!Epi::AFTER_DRAIN) { E(acc, cur, wr, wc, fr, fq); S.done(cur); }
        if (!has_next) break;
#pragma unroll
        for (int a = 0; a < 2; ++a)
#pragma unroll
            for (int b = 0; b < 2; ++b)
#pragma unroll
                for (int m = 0; m < 4; ++m)
#pragma unroll
                    for (int n = 0; n < 2; ++n) acc[a][b][m][n] = (f32x4){0.f, 0.f, 0.f, 0.f};
        cur = nxt; cA = nA; cB = nB; ++ui;
        if constexpr (ALIGN_EPI) { if (wr == 1) PG8_BAR; }
    }
    PG8_WAIT_V(0);
    if constexpr (!ALIGN_EPI) { if (wr == 0) PG8_BAR; }
    PG8_BAR;
    if constexpr (Epi::AFTER_DRAIN) { E.fused(acc, cur, wr, wc, fr, fq, lds, wid, lane); S.done(cur); }
#undef PG8_SA
#undef PG8_SB
#undef PG8_STAGE
#undef PG8_LDA
#undef PG8_LDB
#undef PG8_MMA
#undef PG8_WAIT_V
#undef PG8_WAIT_L
#undef PG8_BAR
#undef PG8_SCHED
}
}
#ifndef PG8_SP2
#define PG8_SP2 true
#endif
#ifndef PG8_ALIGN
#define PG8_ALIGN true
#endif
constexpr int S_ = 8192, DM = 2048, DFF = 5632, NPROJ = 13056, NGU = 2 * DFF;
constexpr int IN_W = 12880;
constexpr int C_AQ = 0, C_AK = 1024, C_AV = 2048, C_IQ = 3072, C_BQ = 4096, C_BK = 5632, C_BV = 7168, C_GA = 8704, C_GB = 10752, C_IK = 12800, C_IW = 12864;
constexpr float ALPHA = 1.189207115002721f;
constexpr float LN_EPS = 1e-5f;
constexpr int TOPK = 256;

constexpr size_t MiB = 1u << 20;
constexpr size_t WS_CTL = 0;
constexpr size_t WS_WT_IN = 1 * MiB, WS_WT_A = 52 * MiB, WS_WT_B = 56 * MiB, WS_WT_OUT = 58 * MiB, WS_WT_GU = 66 * MiB, WS_WT_DOWN = 110 * MiB;
constexpr size_t WS_XB = 132 * MiB, WS_MERGED = 132 * MiB;
constexpr size_t WS_PROJ = 164 * MiB;
constexpr size_t WS_OA = 1 * MiB, WS_OB = 17 * MiB, WS_SELIDX = 25 * MiB, WS_SELCNT = 33 * MiB, WS_MASK = 34 * MiB;
constexpr size_t WS_H = 164 * MiB, WS_HB = 228 * MiB, WS_ACT = 260 * MiB;
constexpr size_t WS_END = 368 * MiB;
static_assert(WS_WT_IN + (size_t)NPROJ * DM * 2 <= WS_WT_A && WS_WT_GU + (size_t)NGU * DM * 2 <= WS_WT_DOWN && WS_WT_DOWN + (size_t)DM * DFF * 2 <= WS_XB, "ws map 1");
static_assert(WS_PROJ + (size_t)S_ * NPROJ * 2 <= WS_END && WS_ACT + (size_t)S_ * DFF * 2 <= WS_END && WS_MASK + 8 * MiB <= WS_WT_A, "ws map 2");

#define GAS __attribute__((address_space(1)))
#define LAS __attribute__((address_space(3)))
typedef unsigned short bf16;
typedef unsigned v4u __attribute__((ext_vector_type(4)));
typedef float f32x4 __attribute__((ext_vector_type(4)));
__device__ __forceinline__ unsigned f2bf(float f) { unsigned u = __builtin_bit_cast(unsigned, f); return (u + 0x7fffu + ((u >> 16) & 1u)) >> 16; }
__device__ __forceinline__ unsigned pk2(float lo, float hi) { return f2bf(lo) | (f2bf(hi) << 16); }
__device__ __forceinline__ float bf2f(bf16 v) { return __uint_as_float((unsigned)v << 16); }
__device__ __forceinline__ float wave_sum(float v) {
#pragma unroll
    for (int o = 1; o < 64; o <<= 1) v += __shfl_xor(v, o);
    return v;
}
__device__ __forceinline__ float wave_max(float v) {
#pragma unroll
    for (int o = 1; o < 64; o <<= 1) v = fmaxf(v, __shfl_xor(v, o));
    return v;
}

__device__ __forceinline__ void transpose_item(const float* W, int Nsrc, int K, bf16* WT, int n0, int k0, int srccol0, int nvalid, float* scr, int lane) {
#pragma unroll 8
    for (int i = 0; i < 32; ++i) { const int kk = 2 * i + (lane >> 5); const int c = lane & 31;
        scr[kk * 33 + c] = (c < nvalid) ? W[(size_t)(k0 + kk) * Nsrc + srccol0 + c] : 0.f; }
    __builtin_amdgcn_s_waitcnt(0xc07f); asm volatile("" ::: "memory");
    const int c = lane & 7;
#pragma unroll
    for (int j = 0; j < 4; ++j) { const int n = (lane >> 3) + 8 * j; const float* s = scr + (8 * c) * 33 + n;
        v4u o; o.x = pk2(s[0 * 33], s[1 * 33]); o.y = pk2(s[2 * 33], s[3 * 33]); o.z = pk2(s[4 * 33], s[5 * 33]); o.w = pk2(s[6 * 33], s[7 * 33]);
        *(v4u*)(WT + (size_t)(n0 + n) * K + k0 + 8 * c) = o; }
    __builtin_amdgcn_s_waitcnt(0xc07f); asm volatile("" ::: "memory");
}
struct ProArgs { const float *x, *w_in, *w_a, *w_b, *w_out, *w_gate, *w_up, *w_down; unsigned char* ws; };
__device__ __forceinline__ void prologue_body(const ProArgs& a, float* scr  , int gw, int NGW, int lane) {
    bf16* wt_in = (bf16*)(a.ws + WS_WT_IN); bf16* wt_a = (bf16*)(a.ws + WS_WT_A); bf16* wt_b = (bf16*)(a.ws + WS_WT_B); bf16* wt_out = (bf16*)(a.ws + WS_WT_OUT);
    bf16* wt_gu = (bf16*)(a.ws + WS_WT_GU); bf16* wt_down = (bf16*)(a.ws + WS_WT_DOWN); bf16* xb = (bf16*)(a.ws + WS_XB);
    constexpr int I_IN = (DM / 64) * (NPROJ / 32), I_A = (1024 / 64) * (DM / 32), I_B = (512 / 64) * (DM / 32), I_OUT = (DM / 64) * (DM / 32), I_GU = (DM / 64) * (NGU / 32), I_DN = (DFF / 64) * (DM / 32);
    constexpr int NITEMS = I_IN + I_A + I_B + I_OUT + I_GU + I_DN;
    for (int it = gw; it < NITEMS; it += NGW) {
        int r = it;
        if (r < I_IN) { const int nb = r % (NPROJ / 32), kb = r / (NPROJ / 32), n0 = nb * 32;
            int src, nv = 32;
            if (n0 < 4096) src = n0; else if (n0 < 12800) src = n0 + 80; else if (n0 < 12880) { src = n0 - 12800 + 4096; nv = (12880 - n0) < 32 ? (12880 - n0) : 32; } else { src = 0; nv = 0; }
            transpose_item(a.w_in, IN_W, DM, wt_in, n0, kb * 64, src, nv, scr, lane); continue; }
        r -= I_IN;
        if (r < I_A) { const int nb = r % (DM / 32), kb = r / (DM / 32); transpose_item(a.w_a, DM, 1024, wt_a, nb * 32, kb * 64, nb * 32, 32, scr, lane); continue; }
        r -= I_A;
        if (r < I_B) { const int nb = r % (DM / 32), kb = r / (DM / 32); transpose_item(a.w_b, DM, 512, wt_b, nb * 32, kb * 64, nb * 32, 32, scr, lane); continue; }
        r -= I_B;
        if (r < I_OUT) { const int nb = r % (DM / 32), kb = r / (DM / 32); transpose_item(a.w_out, DM, DM, wt_out, nb * 32, kb * 64, nb * 32, 32, scr, lane); continue; }
        r -= I_OUT;
        if (r < I_GU) { const int nb = r % (NGU / 32), kb = r / (NGU / 32), n0 = nb * 32; const int half = (n0 >> 7) & 1, j = n0 >> 8, i = n0 & 127;
            transpose_item(half ? a.w_up : a.w_gate, DFF, DM, wt_gu, n0, kb * 64, 128 * j + i, 32, scr, lane); continue; }
        r -= I_GU;
        { const int nb = r % (DM / 32), kb = r / (DM / 32); transpose_item(a.w_down, DM, DFF, wt_down, nb * 32, kb * 64, nb * 32, 32, scr, lane); }
    }
    for (int m = gw; m < S_; m += NGW) {
        const f32x4* xr = (const f32x4*)(a.x + (size_t)m * DM) + lane; unsigned long long* o8 = (unsigned long long*)(xb + (size_t)m * DM) + lane;
#pragma unroll
        for (int j = 0; j < 8; ++j) { const f32x4 v = xr[64 * j]; o8[64 * j] = (unsigned long long)pk2(v.x, v.y) | ((unsigned long long)pk2(v.z, v.w) << 32); }
    }
}
__global__ void __launch_bounds__(256) prologue_kernel(ProArgs a) {
    __shared__ float scr[4][64 * 33];
    const int lane = threadIdx.x & 63, w = threadIdx.x >> 6;
    prologue_body(a, scr[w], blockIdx.x * 4 + w, gridDim.x * 4, lane);
}

struct GArgs { const float* x; float* out; unsigned char* ws; int phase; int pad; };
constexpr int GEMM_LDS = pg8::STAGE_BYTES;
__global__ void __launch_bounds__(512, 2) gemm_kernel(GArgs a) {
    extern __shared__ __attribute__((aligned(16))) unsigned char lds_raw[];
    LAS unsigned char* lds = (LAS unsigned char*)lds_raw;
    unsigned char* ws = a.ws; const int G = gridDim.x, c = blockIdx.x;
    using pg8::bf16_t;
    if (a.phase == 1) {
        pg8::Gemm g{(const bf16_t*)(ws + WS_XB), (const bf16_t*)(ws + WS_WT_IN), S_, NPROJ, DM}; pg8::StaticOrder S; S.init(S_, NPROJ, G, c);
        pg8::EpiProj E{(bf16_t*)(ws + WS_PROJ), NPROJ, C_GA, C_IK};
        pg8::gemm_phase<pg8::EpiProj, pg8::StaticOrder, PG8_ALIGN, PG8_SP2>(lds, g, S, E);
    } else if (a.phase == 4) {
        pg8::Gemm g{(const bf16_t*)(ws + WS_OA), (const bf16_t*)(ws + WS_WT_A), S_, DM, 1024}; pg8::StaticOrder S; S.init(S_, DM, G, c);
        pg8::EpiMerge<1> E{(const bf16_t*)(ws + WS_PROJ), NPROJ, C_GA, a.out, DM, nullptr, 0};
        pg8::gemm_phase<pg8::EpiMerge<1>, pg8::StaticOrder, PG8_ALIGN, PG8_SP2>(lds, g, S, E);
    } else if (a.phase == 5) {
        pg8::Gemm g{(const bf16_t*)(ws + WS_OB), (const bf16_t*)(ws + WS_WT_B), S_, DM, 512}; pg8::StaticOrder S; S.init(S_, DM, G, c);
        pg8::EpiMerge<2> E{(const bf16_t*)(ws + WS_PROJ), NPROJ, C_GB, a.out, DM, (bf16_t*)(ws + WS_MERGED), DM};
        pg8::gemm_phase<pg8::EpiMerge<2>, pg8::StaticOrder, PG8_ALIGN, PG8_SP2>(lds, g, S, E);
    } else if (a.phase == 6) {
        pg8::Gemm g{(const bf16_t*)(ws + WS_MERGED), (const bf16_t*)(ws + WS_WT_OUT), S_, DM, DM}; pg8::StaticOrder S; S.init(S_, DM, G, c);
        pg8::EpiRes E{a.x, (float*)(ws + WS_H), DM, ALPHA};
        pg8::gemm_phase<pg8::EpiRes, pg8::StaticOrder, PG8_ALIGN, PG8_SP2>(lds, g, S, E);
    } else if (a.phase == 7) {
        pg8::Gemm g{(const bf16_t*)(ws + WS_HB), (const bf16_t*)(ws + WS_WT_GU), S_, NGU, DM}; pg8::StaticOrder S; S.init(S_, NGU, G, c);
        pg8::EpiSwiGLU E{(bf16_t*)(ws + WS_ACT), DFF};
        pg8::gemm_phase<pg8::EpiSwiGLU, pg8::StaticOrder, PG8_ALIGN, PG8_SP2>(lds, g, S, E);
    } else if (a.phase == 8) {
        pg8::Gemm g{(const bf16_t*)(ws + WS_ACT), (const bf16_t*)(ws + WS_WT_DOWN), S_, DM, DFF}; pg8::StaticOrder S; S.init(S_, DM, G, c);
        pg8::EpiRes E{(const float*)(ws + WS_H), a.out, DM, ALPHA};
        pg8::gemm_phase<pg8::EpiRes, pg8::StaticOrder, PG8_ALIGN, PG8_SP2>(lds, g, S, E);
    }
}

__global__ void __launch_bounds__(256) ln_kernel(const float* Y, const float* g, const float* b, float* outf, bf16* outb) {
    const int lane = threadIdx.x & 63; const int row = blockIdx.x * 4 + (threadIdx.x >> 6);
    const f32x4* yr = (const f32x4*)(Y + (size_t)row * DM) + lane;
    f32x4 v[8]; float s = 0.f;
#pragma unroll
    for (int j = 0; j < 8; ++j) { v[j] = yr[64 * j]; s += (v[j].x + v[j].y) + (v[j].z + v[j].w); }
    const float mean = wave_sum(s) * (1.f / DM); float s2 = 0.f;
#pragma unroll
    for (int j = 0; j < 8; ++j) { v[j] = v[j] - mean; s2 += (v[j].x * v[j].x + v[j].y * v[j].y) + (v[j].z * v[j].z + v[j].w * v[j].w); }
    const float rstd = 1.f / sqrtf(wave_sum(s2) * (1.f / DM) + LN_EPS);
#pragma unroll
    for (int j = 0; j < 8; ++j) { const f32x4 gg = ((const f32x4*)g)[lane + 64 * j], bb = ((const f32x4*)b)[lane + 64 * j]; const f32x4 o = v[j] * rstd * gg + bb;
        ((f32x4*)(outf + (size_t)row * DM))[lane + 64 * j] = o;
        if (outb) ((unsigned long long*)(outb + (size_t)row * DM))[lane + 64 * j] = (unsigned long long)pk2(o.x, o.y) | ((unsigned long long)pk2(o.z, o.w) << 32); }
}

__device__ __forceinline__ unsigned ord_key(float f) { unsigned u = __float_as_uint(f); return (u & 0x80000000u) ? ~u : (u | 0x80000000u); }
__device__ __forceinline__ unsigned block_exscan(unsigned v, unsigned* sh  , unsigned* tot) {
    const int lane = threadIdx.x & 63, w = threadIdx.x >> 6;
    unsigned inc = v;
#pragma unroll
    for (int o = 1; o < 64; o <<= 1) { unsigned t = __shfl_up(inc, o); if (lane >= o) inc += t; }
    __syncthreads();
    if (lane == 63) sh[w] = inc;
    __syncthreads();
    unsigned base = 0, total = 0;
    for (int i = 0; i < 4; ++i) { const unsigned s = sh[i]; if (i < w) base += s; total += s; }
    *tot = total;
    return base + inc - v;
}
__global__ void __launch_bounds__(256) naive_topk_kernel(const bf16* proj, int* sel_idx, int* sel_cnt) {
    __shared__ float sc[S_];
    __shared__ float qs[1024];
    __shared__ float wsh[16];
    __shared__ unsigned hist[256];
    __shared__ unsigned shs[8];
    __shared__ unsigned sh_prefix, sh_r;
    const int tid = threadIdx.x; const int t = S_ - 1 - (int)blockIdx.x; const int n = t + 1;
    const bf16* prow = proj + (size_t)t * NPROJ;
    for (int i = tid; i < 1024; i += 256) qs[i] = bf2f(prow[C_IQ + i]);
    if (tid < 16) wsh[tid] = bf2f(prow[C_IW + tid]) * 0.25f;
    __syncthreads();
    for (int s = tid; s < n; s += 256) {
        const bf16* kr = proj + (size_t)s * NPROJ + C_IK; float kf[64];
#pragma unroll
        for (int i = 0; i < 8; ++i) { const v4u w = ((const v4u*)kr)[i];
            kf[8 * i + 0] = __uint_as_float(w.x << 16); kf[8 * i + 1] = __uint_as_float(w.x & 0xffff0000u); kf[8 * i + 2] = __uint_as_float(w.y << 16); kf[8 * i + 3] = __uint_as_float(w.y & 0xffff0000u);
            kf[8 * i + 4] = __uint_as_float(w.z << 16); kf[8 * i + 5] = __uint_as_float(w.z & 0xffff0000u); kf[8 * i + 6] = __uint_as_float(w.w << 16); kf[8 * i + 7] = __uint_as_float(w.w & 0xffff0000u); }
        float score = 0.f;
        for (int h = 0; h < 16; ++h) { float d = 0.f;
#pragma unroll
            for (int i = 0; i < 64; ++i) d = fmaf(qs[h * 64 + i], kf[i], d);
            score = fmaf(wsh[h], fmaxf(d * 0.125f, 0.f), score); }
        sc[s] = score;
    }
    __syncthreads();
    int* out = sel_idx + (size_t)t * TOPK;
    if (n <= TOPK) { if (tid < TOPK) out[tid] = tid < n ? tid : -1; if (tid == 0) sel_cnt[t] = n; return; }
    if (tid == 0) { sh_prefix = 0u; sh_r = TOPK; }
    unsigned maskbits = 0u;
    for (int round = 0; round < 4; ++round) {
        const int shift = 24 - 8 * round;
        hist[tid] = 0u;
        __syncthreads();
        const unsigned prefix = sh_prefix;
        for (int s = tid; s < n; s += 256) { const unsigned k = ord_key(sc[s]); if ((k & maskbits) == prefix) atomicAdd(&hist[(k >> shift) & 255u], 1u); }
        __syncthreads();
        if (tid == 0) { unsigned r = sh_r, cum = 0; int b = 255; for (; b > 0; --b) { if (cum + hist[b] >= r) break; cum += hist[b]; } sh_r = r - cum; sh_prefix = prefix | ((unsigned)b << shift); }
        maskbits |= 255u << shift;
        __syncthreads();
    }
    const unsigned tau = sh_prefix; const unsigned rt = sh_r;
    const int s0 = tid * 32;
    unsigned nt = 0; for (int i = 0; i < 32; ++i) { const int s = s0 + i; if (s < n && ord_key(sc[s]) == tau) ++nt; }
    unsigned tot; unsigned tbase = block_exscan(nt, shs, &tot);
    unsigned ns = 0, tr = tbase; unsigned flags = 0;
    for (int i = 0; i < 32; ++i) { const int s = s0 + i; if (s < n) { const unsigned k = ord_key(sc[s]); bool sel = k > tau; if (k == tau) { sel = tr < rt; ++tr; } if (sel) { flags |= 1u << i; ++ns; } } }
    unsigned sbase = block_exscan(ns, shs, &tot);
    for (int i = 0; i < 32; ++i) if (flags & (1u << i)) out[sbase++] = s0 + i;
    if (tid == 0) sel_cnt[t] = (int)tot;
}
__global__ void __launch_bounds__(256) naive_attn_a_kernel(const bf16* proj, const int* sel_idx, const int* sel_cnt, bf16* oa) {
    __shared__ float qsh[1024];
    __shared__ float pw[4][TOPK];
    __shared__ int sel[TOPK];
    const int tid = threadIdx.x, lane = tid & 63, w = tid >> 6; const int t = S_ - 1 - (int)blockIdx.x;
    const bf16* prow = proj + (size_t)t * NPROJ;
    for (int i = tid; i < 1024; i += 256) qsh[i] = bf2f(prow[C_AQ + i]);
    sel[tid] = sel_idx[(size_t)t * TOPK + tid];
    const int cnt = sel_cnt[t];
    __syncthreads();
    for (int hh = 0; hh < 2; ++hh) {
        const int h = 2 * w + hh; const float slope = exp2f(-0.4f * (float)(13 + h)); const float* q = qsh + h * 128;
        float lg[4]; float mx = -INFINITY;
#pragma unroll
        for (int i = 0; i < 4; ++i) { const int k = lane + 64 * i; lg[i] = -INFINITY;
            if (k < cnt) { const int s = sel[k]; const v4u* kr = (const v4u*)(proj + (size_t)s * NPROJ + C_AK + h * 128); float d = 0.f;
                for (int c = 0; c < 16; ++c) { const v4u wv = kr[c];
                    d = fmaf(q[8 * c + 0], __uint_as_float(wv.x << 16), d); d = fmaf(q[8 * c + 1], __uint_as_float(wv.x & 0xffff0000u), d);
                    d = fmaf(q[8 * c + 2], __uint_as_float(wv.y << 16), d); d = fmaf(q[8 * c + 3], __uint_as_float(wv.y & 0xffff0000u), d);
                    d = fmaf(q[8 * c + 4], __uint_as_float(wv.z << 16), d); d = fmaf(q[8 * c + 5], __uint_as_float(wv.z & 0xffff0000u), d);
                    d = fmaf(q[8 * c + 6], __uint_as_float(wv.w << 16), d); d = fmaf(q[8 * c + 7], __uint_as_float(wv.w & 0xffff0000u), d); }
                lg[i] = d * 0.08838834764831845f - slope * (float)(t - s); }
            mx = fmaxf(mx, lg[i]); }
        mx = wave_max(mx); float sum = 0.f;
#pragma unroll
        for (int i = 0; i < 4; ++i) { lg[i] = (lane + 64 * i < cnt) ? __expf(lg[i] - mx) : 0.f; sum += lg[i]; }
        sum = wave_sum(sum); const float inv = 1.f / sum;
#pragma unroll
        for (int i = 0; i < 4; ++i) pw[w][lane + 64 * i] = lg[i] * inv;
        __builtin_amdgcn_s_waitcnt(0xc07f); asm volatile("" ::: "memory");
        float o0 = 0.f, o1 = 0.f;
        for (int k = 0; k < cnt; ++k) { const int s = sel[k]; const unsigned vv = *(const unsigned*)(proj + (size_t)s * NPROJ + C_AV + h * 128 + 2 * lane); const float p = pw[w][k];
            o0 = fmaf(p, __uint_as_float(vv << 16), o0); o1 = fmaf(p, __uint_as_float(vv & 0xffff0000u), o1); }
        *(unsigned*)(oa + (size_t)t * 1024 + h * 128 + 2 * lane) = pk2(o0, o1);
        __builtin_amdgcn_s_waitcnt(0xc07f); asm volatile("" ::: "memory");
    }
}
__global__ void __launch_bounds__(256) naive_attn_b_kernel(const bf16* proj, bf16* ob) {
    __shared__ float qsh[4][3][128];
    __shared__ float pw[4][3 * 129 + 1];
    const int tid = threadIdx.x, lane = tid & 63, w = tid >> 6; const int t = blockIdx.x;
    const bf16* prow = proj + (size_t)t * NPROJ;
    for (int g = 0; g < 3; ++g) for (int i = lane; i < 128; i += 64) qsh[w][g][i] = bf2f(prow[C_BQ + (4 * g + w) * 128 + i]);
    __builtin_amdgcn_s_waitcnt(0xc07f); asm volatile("" ::: "memory");
    float mx = -INFINITY;
    for (int g = 0; g < 3; ++g) { const int d = g == 0 ? 1 : (g == 1 ? 4 : 16); const int m = t / d; const int nk = (m < 128 ? m : 128) + 1; const int head = 4 * g + w;
        const float slope = exp2f(-0.4f * (float)(head + 1)); const float* q = qsh[w][g];
        for (int i = lane; i < 129; i += 64) { float l = -INFINITY;
            if (i < nk) { const int s = t - i * d; const v4u* kr = (const v4u*)(proj + (size_t)s * NPROJ + C_BK + head * 128); float dd = 0.f;
                for (int c = 0; c < 16; ++c) { const v4u wv = kr[c];
                    dd = fmaf(q[8 * c + 0], __uint_as_float(wv.x << 16), dd); dd = fmaf(q[8 * c + 1], __uint_as_float(wv.x & 0xffff0000u), dd);
                    dd = fmaf(q[8 * c + 2], __uint_as_float(wv.y << 16), dd); dd = fmaf(q[8 * c + 3], __uint_as_float(wv.y & 0xffff0000u), dd);
                    dd = fmaf(q[8 * c + 4], __uint_as_float(wv.z << 16), dd); dd = fmaf(q[8 * c + 5], __uint_as_float(wv.z & 0xffff0000u), dd);
                    dd = fmaf(q[8 * c + 6], __uint_as_float(wv.w << 16), dd); dd = fmaf(q[8 * c + 7], __uint_as_float(wv.w & 0xffff0000u), dd); }
                l = dd * 0.08838834764831845f - slope * (float)(i * d); }
            pw[w][g * 129 + i] = l; mx = fmaxf(mx, l); } }
    mx = wave_max(mx);
    __builtin_amdgcn_s_waitcnt(0xc07f); asm volatile("" ::: "memory");
    float sum = 0.f;
    for (int i = lane; i < 387; i += 64) { const float p = __expf(pw[w][i] - mx); pw[w][i] = p; sum += p; }
    sum = wave_sum(sum); const float inv = 1.f / sum;
    __builtin_amdgcn_s_waitcnt(0xc07f); asm volatile("" ::: "memory");
    float o0 = 0.f, o1 = 0.f;
    for (int g = 0; g < 3; ++g) { const int d = g == 0 ? 1 : (g == 1 ? 4 : 16); const int m = t / d; const int nk = (m < 128 ? m : 128) + 1; const int head = 4 * g + w;
        for (int i = 0; i < nk; ++i) { const int s = t - i * d; const unsigned vv = *(const unsigned*)(proj + (size_t)s * NPROJ + C_BV + head * 128 + 2 * lane); const float p = pw[w][g * 129 + i];
            o0 = fmaf(p, __uint_as_float(vv << 16), o0); o1 = fmaf(p, __uint_as_float(vv & 0xffff0000u), o1); } }
    *(unsigned*)(ob + (size_t)t * 512 + w * 128 + 2 * lane) = pk2(o0 * inv, o1 * inv);
}

extern "C" void kernel_launch(void* const* d_in, const int* in_sizes, int n_in, void* d_out, int out_size, void* d_ws, size_t ws_size, hipStream_t stream) {
    static int grid = 0;
    if (grid == 0) {
        if (n_in != 12 || in_sizes[0] != S_ * DM || out_size != S_ * DM || ws_size < WS_END) { fprintf(stderr, "kernel_launch: unexpected shapes / workspace (n_in %d, in0 %d, out %d, ws %zu)\n", n_in, n_in > 0 ? in_sizes[0] : -1, out_size, ws_size); grid = -1; return; }
        int dev = 0, cus = 0;
        if (hipGetDevice(&dev) != hipSuccess || hipDeviceGetAttribute(&cus, hipDeviceAttributeMultiprocessorCount, dev) != hipSuccess) { grid = -1; return; }
        if (hipFuncSetAttribute((const void*)gemm_kernel, hipFuncAttributeMaxDynamicSharedMemorySize, GEMM_LDS) != hipSuccess) { fprintf(stderr, "kernel_launch: hipFuncSetAttribute failed\n"); grid = -1; return; }
        grid = cus;
    }
    if (grid < 0) return;
    const float* x = (const float*)d_in[0];
    unsigned char* ws = (unsigned char*)d_ws; float* out = (float*)d_out;
    ProArgs pa{x, (const float*)d_in[1], (const float*)d_in[2], (const float*)d_in[3], (const float*)d_in[4], (const float*)d_in[7], (const float*)d_in[8], (const float*)d_in[9], ws};
    hipLaunchKernelGGL(prologue_kernel, dim3(2048), dim3(256), 0, stream, pa);
    GArgs ga{}; ga.x = x; ga.out = out; ga.ws = ws;
    ga.phase = 1; hipLaunchKernelGGL(gemm_kernel, dim3(grid), dim3(512), GEMM_LDS, stream, ga);
    const bf16* proj = (const bf16*)(ws + WS_PROJ);
    hipLaunchKernelGGL(naive_topk_kernel, dim3(S_), dim3(256), 0, stream, proj, (int*)(ws + WS_SELIDX), (int*)(ws + WS_SELCNT));
    hipLaunchKernelGGL(naive_attn_a_kernel, dim3(S_), dim3(256), 0, stream, proj, (const int*)(ws + WS_SELIDX), (const int*)(ws + WS_SELCNT), (bf16*)(ws + WS_OA));
    hipLaunchKernelGGL(naive_attn_b_kernel, dim3(S_), dim3(256), 0, stream, proj, (bf16*)(ws + WS_OB));
    ga.phase = 4; hipLaunchKernelGGL(gemm_kernel, dim3(grid), dim3(512), GEMM_LDS, stream, ga);
    ga.phase = 5; hipLaunchKernelGGL(gemm_kernel, dim3(grid), dim3(512), GEMM_LDS, stream, ga);
    ga.phase = 6; hipLaunchKernelGGL(gemm_kernel, dim3(grid), dim3(512), GEMM_LDS, stream, ga);
    hipLaunchKernelGGL(ln_kernel, dim3(S_ / 4), dim3(256), 0, stream, (const float*)(ws + WS_H), (const float*)d_in[5], (const float*)d_in[6], (float*)(ws + WS_H), (bf16*)(ws + WS_HB));
    ga.phase = 7; hipLaunchKernelGGL(gemm_kernel, dim3(grid), dim3(512), GEMM_LDS, stream, ga);
    ga.phase = 8; hipLaunchKernelGGL(gemm_kernel, dim3(grid), dim3(512), GEMM_LDS, stream, ga);
    hipLaunchKernelGGL(ln_kernel, dim3(S_ / 4), dim3(256), 0, stream, (const float*)out, (const float*)d_in[10], (const float*)d_in[11], out, (bf16*)nullptr);
}
```

```cpp
#include <hip/hip_runtime.h>
#include <cstdio>
#include <cstdint>
namespace pg8 {
#define PG8_LAS __attribute__((address_space(3)))
typedef unsigned short bf16_t;
typedef short bf16x8 __attribute__((ext_vector_type(8)));
typedef float f32x4 __attribute__((ext_vector_type(4)));
typedef unsigned u32x4 __attribute__((ext_vector_type(4)));
constexpr int BM = 256, BK = 64, HALF = 128, HTB = HALF * BK * 2  , STAGE_BYTES = 8 * HTB, NXCD = 8, WGM = 8;

__host__ __device__ __forceinline__ int lds_byte(int r, int c) { const int st = (r >> 4) * 2 + (c >> 5), rr = r & 15, cc = c & 31, ob = rr * 64 + cc * 2; return st * 1024 + (ob ^ (((ob >> 9) & 1) << 5)); }
__host__ __device__ __forceinline__ void stage_rc(int b, int& R, int& C) { const int st = b / 1024, sb = b % 1024, swz = sb ^ (((sb >> 9) & 1) << 5); R = (st >> 1) * 16 + swz / 64; C = (st & 1) * 32 + (swz % 64) / 2; }
__host__ __device__ __forceinline__ int perm32(int rho) { const int n = rho >> 4, i = rho & 15; return 8 * (i >> 2) + 4 * n + (i & 3); }

struct Unit { int pm, pn; };
struct Gemm { const bf16_t* A; const bf16_t* Bt; int M, N, K; };

struct StaticOrder {
    int nM, nN, nwg, G, c;
    __host__ __device__ void init(int M, int N, int G_, int c_) { nM = M / BM; nN = N / BM; nwg = nM * nN; G = G_; c = c_; }
    __host__ __device__ bool next(int i, Unit& u) const {
        const long L = (long)i * G + c; if (L >= nwg) return false;
        int wgid = (int)L; { const int q = nwg / NXCD, r = nwg % NXCD, xcd = wgid % NXCD, off = wgid / NXCD; wgid = (xcd < r ? xcd * (q + 1) : r * (q + 1) + (xcd - r) * q) + off; }
        const int nig = WGM * nN, gid = wgid / nig, fm = gid * WGM, gsz = (nM - fm) < WGM ? (nM - fm) : WGM;
        u.pm = fm + ((wgid % nig) % gsz); u.pn = (wgid % nig) / gsz; return true;
    }
    __device__ __forceinline__ void a_ready(const Unit&) const {}
    __device__ __forceinline__ void done(const Unit&) const {}
};

__device__ __forceinline__ unsigned cvt_pk_bf16(float lo, float hi) { unsigned r; asm volatile("v_cvt_pk_bf16_f32 %0, %1, %2" : "=v"(r) : "v"(lo), "v"(hi)); return r; }
__device__ __forceinline__ float bf_lo(unsigned w) { return __uint_as_float(w << 16); }
__device__ __forceinline__ float bf_hi(unsigned w) { return __uint_as_float(w & 0xffff0000u); }
__device__ __forceinline__ float sigmoidf_fast(float v) { return __builtin_amdgcn_rcpf(1.0f + __builtin_amdgcn_exp2f(-1.4426950408889634f * v)); }

struct EpiProj {
    static constexpr bool PERM = true, AFTER_DRAIN = false;
    bf16_t* O; int ldc; int sig_lo, sig_hi;
    __device__ __forceinline__ void operator()(const f32x4 (&acc)[2][2][4][2], const Unit& u, int wr, int wc, int fr, int fq) const {
        const int row0 = u.pm * BM + wr * 64 + fr; const int colt = u.pn * BM; const bool sg = colt >= sig_lo && colt < sig_hi;
        const int col0 = colt + wc * 32 + 8 * fq;
#pragma unroll
        for (int ai = 0; ai < 2; ++ai)
#pragma unroll
            for (int m = 0; m < 4; ++m) { bf16_t* rowp = O + (size_t)(row0 + ai * HALF + m * 16) * ldc + col0;
#pragma unroll
                for (int bj = 0; bj < 2; ++bj) { f32x4 v0 = acc[ai][bj][m][0], v1 = acc[ai][bj][m][1];
                    if (sg) {
#pragma unroll
                        for (int e = 0; e < 4; ++e) { v0[e] = sigmoidf_fast(v0[e]); v1[e] = sigmoidf_fast(v1[e]); } }
                    u32x4 w; w.x = cvt_pk_bf16(v0[0], v0[1]); w.y = cvt_pk_bf16(v0[2], v0[3]); w.z = cvt_pk_bf16(v1[0], v1[1]); w.w = cvt_pk_bf16(v1[2], v1[3]);
                    *(u32x4*)(rowp + bj * HALF) = w; } }
    }
};
template <int PART> struct EpiMerge {
    static constexpr bool PERM = true, AFTER_DRAIN = false;
    const bf16_t* G; int ldg; int gcol; float* T; int ldt; bf16_t* O; int ldo;
    __device__ __forceinline__ void operator()(const f32x4 (&acc)[2][2][4][2], const Unit& u, int wr, int wc, int fr, int fq) const {
        const int row0 = u.pm * BM + wr * 64 + fr; const int col0 = u.pn * BM + wc * 32 + 8 * fq;
#pragma unroll
        for (int ai = 0; ai < 2; ++ai)
#pragma unroll
            for (int m = 0; m < 4; ++m) { const size_t row = (size_t)(row0 + ai * HALF + m * 16);
#pragma unroll
                for (int bj = 0; bj < 2; ++bj) { const int col = col0 + bj * HALF;
                    const u32x4 gw = *(const u32x4*)(G + row * ldg + gcol + col);
                    f32x4 g0 = {bf_lo(gw.x), bf_hi(gw.x), bf_lo(gw.y), bf_hi(gw.y)}, g1 = {bf_lo(gw.z), bf_hi(gw.z), bf_lo(gw.w), bf_hi(gw.w)};
                    f32x4 v0 = acc[ai][bj][m][0] * g0, v1 = acc[ai][bj][m][1] * g1;
                    float* tp = T + row * ldt + col;
                    if (PART == 1) { *(f32x4*)tp = v0; *(f32x4*)(tp + 4) = v1; }
                    else { v0 = v0 + *(const f32x4*)tp; v1 = v1 + *(const f32x4*)(tp + 4);
                        u32x4 w; w.x = cvt_pk_bf16(v0[0], v0[1]); w.y = cvt_pk_bf16(v0[2], v0[3]); w.z = cvt_pk_bf16(v1[0], v1[1]); w.w = cvt_pk_bf16(v1[2], v1[3]);
                        *(u32x4*)(O + row * ldo + col) = w; } } }
    }
};
struct EpiRes {
    static constexpr bool PERM = false, AFTER_DRAIN = false;
    const float* R; float* Y; int ldc; float alpha;
    __device__ __forceinline__ void operator()(const f32x4 (&acc)[2][2][4][2], const Unit& u, int wr, int wc, int fr, int fq) const {
        const int row0 = u.pm * BM + wr * 64 + fr, col0 = u.pn * BM + wc * 32 + 4 * fq;
#pragma unroll
        for (int ai = 0; ai < 2; ++ai)
#pragma unroll
            for (int m = 0; m < 4; ++m) { const size_t off = (size_t)(row0 + ai * HALF + m * 16) * ldc + col0;
#pragma unroll
                for (int bj = 0; bj < 2; ++bj)
#pragma unroll
                    for (int n = 0; n < 2; ++n) { const f32x4 r = *(const f32x4*)(R + off + bj * HALF + n * 16); *(f32x4*)(Y + off + bj * HALF + n * 16) = r * alpha + acc[ai][bj][m][n]; } }
    }
};
struct EpiSwiGLU {
    static constexpr bool PERM = true, AFTER_DRAIN = false;
    bf16_t* O; int ldc;
    __device__ __forceinline__ void operator()(const f32x4 (&acc)[2][2][4][2], const Unit& u, int wr, int wc, int fr, int fq) const {
        const int row0 = u.pm * BM + wr * 64 + fr; const int col0 = u.pn * HALF + wc * 32 + 8 * fq;
#pragma unroll
        for (int ai = 0; ai < 2; ++ai)
#pragma unroll
            for (int m = 0; m < 4; ++m) { f32x4 g0 = acc[ai][0][m][0], g1 = acc[ai][0][m][1]; const f32x4 u0 = acc[ai][1][m][0], u1 = acc[ai][1][m][1];
#pragma unroll
                for (int e = 0; e < 4; ++e) { g0[e] = g0[e] * sigmoidf_fast(g0[e]) * u0[e]; g1[e] = g1[e] * sigmoidf_fast(g1[e]) * u1[e]; }
                u32x4 w; w.x = cvt_pk_bf16(g0[0], g0[1]); w.y = cvt_pk_bf16(g0[2], g0[3]); w.z = cvt_pk_bf16(g1[0], g1[1]); w.w = cvt_pk_bf16(g1[2], g1[3]);
                *(u32x4*)(O + (size_t)(row0 + ai * HALF + m * 16) * ldc + col0) = w; }
    }
};

template <class Epi, class Sched, bool ALIGN_EPI = false, bool SP2 = false>
__device__ __forceinline__ void gemm_phase(PG8_LAS unsigned char* lds, const Gemm g, const Sched& S, const Epi& E) {
    const int tid = threadIdx.x, wid = __builtin_amdgcn_readfirstlane(tid >> 6), lane = tid & 63, wr = wid >> 2, wc = wid & 3, fr = lane & 15, fq = lane >> 4;
    const int K = g.K, nt = K / BK;
    unsigned voffA[2], voffB[2];
#pragma unroll
    for (int i = 0; i < 2; ++i) { int R, C; stage_rc(tid * 16 + i * 8192, R, C); const int Rb = Epi::PERM ? ((R & ~31) + perm32(R & 31)) : R;
        voffA[i] = (unsigned)(R * K + C) * 2u; voffB[i] = (unsigned)(Rb * K + C) * 2u; }
    const size_t kstep = (size_t)(BK * 2);
    const size_t hstep = (size_t)HALF * K * 2;
    const size_t tstep = 2 * hstep;
    const unsigned ldsw = (unsigned)wid * 1024u;
    const int aoff = lds_byte(wr * 64 + fr, fq * 8), boff = lds_byte(wc * 32 + fr, fq * 8);
#define PG8_SA(b, h) (((b) * 2 + (h)) * HTB)
#define PG8_SB(b, h) ((4 + (b) * 2 + (h)) * HTB)
#define PG8_STAGE(bufoff, gbase, voff) do { _Pragma("unroll") for (int _i = 0; _i < 2; ++_i) \
        __builtin_amdgcn_global_load_lds((const unsigned*)((const char*)(gbase) + (voff)[_i]), (PG8_LAS unsigned*)(lds + (bufoff) + ldsw + _i * 8192), 16, 0, 0); } while (0)
#define PG8_LDA(dst, b, h) do { _Pragma("unroll") for (int m = 0; m < 4; ++m) _Pragma("unroll") for (int k = 0; k < 2; ++k) dst[m][k] = *(const PG8_LAS bf16x8*)(lds + PG8_SA(b, h) + aoff + m * 2048 + k * 1024); } while (0)
#define PG8_LDB(dst, b, h) do { _Pragma("unroll") for (int n = 0; n < 2; ++n) _Pragma("unroll") for (int k = 0; k < 2; ++k) dst[n][k] = *(const PG8_LAS bf16x8*)(lds + PG8_SB(b, h) + boff + n * 2048 + k * 1024); } while (0)
#define PG8_MMA(ai, bj, At, Bt) do { __builtin_amdgcn_s_setprio(1); _Pragma("unroll") for (int m = 0; m < 4; ++m) _Pragma("unroll") for (int n = 0; n < 2; ++n) _Pragma("unroll") for (int k = 0; k < 2; ++k) \
        acc[ai][bj][m][n] = __builtin_amdgcn_mfma_f32_16x16x32_bf16(Bt[n][k], At[m][k], acc[ai][bj][m][n], 0, 0, 0); __builtin_amdgcn_s_setprio(0); } while (0)
#define PG8_WAIT_V(n) asm volatile("s_waitcnt vmcnt(" #n ")" ::: "memory")
#define PG8_WAIT_L(n) asm volatile("s_waitcnt lgkmcnt(" #n ")" ::: "memory")
#define PG8_BAR __builtin_amdgcn_s_barrier()
#define PG8_SCHED __builtin_amdgcn_sched_barrier(0)
    Unit cur, nxt; int ui = 0;
    if (!S.next(0, cur)) return;
    f32x4 acc[2][2][4][2];
#pragma unroll
    for (int a = 0; a < 2; ++a)
#pragma unroll
        for (int b = 0; b < 2; ++b)
#pragma unroll
            for (int m = 0; m < 4; ++m)
#pragma unroll
                for (int n = 0; n < 2; ++n) acc[a][b][m][n] = (f32x4){0.f, 0.f, 0.f, 0.f};
    bf16x8 At[4][2], B0[2][2], B1[2][2];
    const char* cA = (const char*)g.A + (size_t)cur.pm * tstep; const char* cB = (const char*)g.Bt + (size_t)cur.pn * tstep;
    S.a_ready(cur);
    if constexpr (SP2) {
        PG8_STAGE(PG8_SB(0, 0), cB, voffB); PG8_STAGE(PG8_SB(0, 1), cB + hstep, voffB); PG8_STAGE(PG8_SA(0, 0), cA, voffA); PG8_STAGE(PG8_SA(0, 1), cA + hstep, voffA);
        if (wr == 1) PG8_BAR;
        PG8_WAIT_V(2); PG8_BAR;
        PG8_STAGE(PG8_SB(1, 0), cB + kstep, voffB); PG8_STAGE(PG8_SA(1, 0), cA + kstep, voffA); PG8_STAGE(PG8_SB(1, 1), cB + hstep + kstep, voffB);
        PG8_WAIT_V(6); PG8_BAR;
    } else {
        PG8_STAGE(PG8_SB(0, 0), cB, voffB); PG8_STAGE(PG8_SA(0, 0), cA, voffA); PG8_STAGE(PG8_SB(0, 1), cB + hstep, voffB); PG8_STAGE(PG8_SA(0, 1), cA + hstep, voffA);
        if (wr == 1) PG8_BAR;
        PG8_WAIT_V(4); PG8_BAR;
        PG8_STAGE(PG8_SB(1, 0), cB + kstep, voffB); PG8_STAGE(PG8_SA(1, 0), cA + kstep, voffA); PG8_STAGE(PG8_SB(1, 1), cB + hstep + kstep, voffB);
        PG8_WAIT_V(6); PG8_BAR;
    }
    for (;;) {
        const bool has_next = S.next(ui + 1, nxt);
        const char* nA = has_next ? (const char*)g.A + (size_t)nxt.pm * tstep : cA; const char* nB = has_next ? (const char*)g.Bt + (size_t)nxt.pn * tstep : cB;
        for (int t = 0; t < nt; t += 2) {
            const bool last = (t == nt - 2);
            const char* a1 = cA + (size_t)(t + 1) * kstep;
            const char* a2 = last ? nA : cA + (size_t)(t + 2) * kstep; const char* b2 = last ? nB : cB + (size_t)(t + 2) * kstep;
            const char* a3 = a2 + kstep; const char* b3 = b2 + kstep;
            if (last && has_next) S.a_ready(nxt);
            if constexpr (SP2) {
            PG8_LDB(B0, 0, 0); PG8_LDB(B1, 0, 1); PG8_SCHED; PG8_LDA(At, 0, 0); PG8_STAGE(PG8_SA(1, 1), a1 + hstep, voffA);
            PG8_WAIT_V(8); PG8_WAIT_L(0); PG8_BAR; PG8_MMA(0, 0, At, B0); PG8_MMA(0, 1, At, B1); PG8_BAR; PG8_SCHED;
            PG8_LDA(At, 0, 1); PG8_STAGE(PG8_SB(0, 0), b2, voffB); PG8_STAGE(PG8_SB(0, 1), b2 + hstep, voffB); PG8_STAGE(PG8_SA(0, 0), a2, voffA);
            PG8_WAIT_V(8); PG8_WAIT_L(0); PG8_BAR; PG8_MMA(1, 0, At, B0); PG8_MMA(1, 1, At, B1); PG8_BAR; PG8_SCHED;
            PG8_LDB(B0, 1, 0); PG8_LDB(B1, 1, 1); PG8_SCHED; PG8_LDA(At, 1, 0); PG8_STAGE(PG8_SA(0, 1), a2 + hstep, voffA);
            PG8_WAIT_V(8); PG8_WAIT_L(0); PG8_BAR; PG8_MMA(0, 0, At, B0); PG8_MMA(0, 1, At, B1); PG8_BAR; PG8_SCHED;
            PG8_LDA(At, 1, 1); PG8_STAGE(PG8_SB(1, 0), b3, voffB); PG8_STAGE(PG8_SB(1, 1), b3 + hstep, voffB); PG8_STAGE(PG8_SA(1, 0), a3, voffA);
            PG8_WAIT_V(8); PG8_WAIT_L(0); PG8_BAR; PG8_MMA(1, 0, At, B0); PG8_MMA(1, 1, At, B1); PG8_BAR; PG8_SCHED;
            } else {
            PG8_LDB(B0, 0, 0); PG8_SCHED; PG8_LDA(At, 0, 0); PG8_STAGE(PG8_SA(1, 1), a1 + hstep, voffA);
            PG8_WAIT_L(8); PG8_BAR; PG8_WAIT_L(0); PG8_MMA(0, 0, At, B0); PG8_BAR; PG8_SCHED;
            PG8_LDB(B1, 0, 1); PG8_STAGE(PG8_SB(0, 0), b2, voffB);
            PG8_BAR; PG8_WAIT_L(0); PG8_MMA(0, 1, At, B1); PG8_BAR;
            PG8_LDA(At, 0, 1); PG8_STAGE(PG8_SA(0, 0), a2, voffA);
            PG8_BAR; PG8_WAIT_L(0); PG8_MMA(1, 0, At, B0); PG8_BAR; PG8_SCHED;
            PG8_STAGE(PG8_SB(0, 1), b2 + hstep, voffB);
            PG8_WAIT_V(6); PG8_BAR; PG8_MMA(1, 1, At, B1); PG8_BAR;
            PG8_LDB(B0, 1, 0); PG8_SCHED; PG8_LDA(At, 1, 0); PG8_STAGE(PG8_SA(0, 1), a2 + hstep, voffA);
            PG8_WAIT_L(8); PG8_BAR; PG8_WAIT_L(0); PG8_MMA(0, 0, At, B0); PG8_BAR; PG8_SCHED;
            PG8_LDB(B1, 1, 1); PG8_STAGE(PG8_SB(1, 0), b3, voffB);
            PG8_BAR; PG8_WAIT_L(0); PG8_MMA(0, 1, At, B1); PG8_BAR;
            PG8_LDA(At, 1, 1); PG8_STAGE(PG8_SA(1, 0), a3, voffA);
            PG8_BAR; PG8_WAIT_L(0); PG8_MMA(1, 0, At, B0); PG8_BAR; PG8_SCHED;
            PG8_STAGE(PG8_SB(1, 1), b3 + hstep, voffB);
            PG8_WAIT_V(6); PG8_BAR; PG8_MMA(1, 1, At, B1); PG8_BAR;
            }
        }
        if constexpr (ALIGN_EPI) { if (wr == 0) PG8_BAR; }
        if constexpr (!Epi::AFTER_DRAIN) { E(acc, cur, wr, wc, fr, fq); S.done(cur); }
        if (!has_next) break;
#pragma unroll
        for (int a = 0; a < 2; ++a)
#pragma unroll
            for (int b = 0; b < 2; ++b)
#pragma unroll
                for (int m = 0; m < 4; ++m)
#pragma unroll
                    for (int n = 0; n < 2; ++n) acc[a][b][m][n] = (f32x4){0.f, 0.f, 0.f, 0.f};
        cur = nxt; cA = nA; cB = nB; ++ui;
        if constexpr (ALIGN_EPI) { if (wr == 1) PG8_BAR; }
    }
    PG8_WAIT_V(0);
    if constexpr (!ALIGN_EPI) { if (wr == 0) PG8_BAR; }
    PG8_BAR;
    if constexpr (Epi::AFTER_DRAIN) { E.fused(acc, cur, wr, wc, fr, fq, lds, wid, lane); S.done(cur); }
#undef PG8_SA
#undef PG8_SB
#undef PG8_STAGE
#undef PG8_LDA
#undef PG8_LDB
#undef PG8_MMA
#undef PG8_WAIT_V
#undef PG8_WAIT_L
#undef PG8_BAR
#undef PG8_SCHED
}
}
#ifndef PG8_SP2
#define PG8_SP2 true
#endif
#ifndef PG8_ALIGN
#define PG8_ALIGN true
#endif
constexpr int S_ = 8192, DM = 2048, DFF = 5632, NPROJ = 13056, NGU = 2 * DFF;
constexpr int IN_W = 12880;
constexpr int C_AQ = 0, C_AK = 1024, C_AV = 2048, C_IQ = 3072, C_BQ = 4096, C_BK = 5632, C_BV = 7168, C_GA = 8704, C_GB = 10752, C_IK = 12800, C_IW = 12864;
constexpr float ALPHA = 1.189207115002721f;
constexpr float LN_EPS = 1e-5f;
constexpr int TOPK = 256;

constexpr size_t MiB = 1u << 20;
constexpr size_t WS_CTL = 0, CTL_ZERO_BYTES = 256 * 1024;
constexpr size_t WS_WT_IN = 1 * MiB, WS_WT_A = 52 * MiB, WS_WT_B = 56 * MiB, WS_WT_OUT = 58 * MiB, WS_WT_GU = 66 * MiB, WS_WT_DOWN = 110 * MiB;
constexpr size_t WS_XB = 132 * MiB, WS_MERGED = 132 * MiB;
constexpr size_t WS_PROJ = 164 * MiB;
constexpr size_t WS_OA = 1 * MiB, WS_OB = 17 * MiB, WS_SELIDX = 25 * MiB, WS_SELCNT = 33 * MiB, WS_MASK = 34 * MiB;
constexpr size_t WS_H = 164 * MiB, WS_HB = 228 * MiB, WS_ACT = 260 * MiB;
constexpr size_t WS_END = 368 * MiB;
static_assert(WS_WT_IN + (size_t)NPROJ * DM * 2 <= WS_WT_A && WS_WT_GU + (size_t)NGU * DM * 2 <= WS_WT_DOWN && WS_WT_DOWN + (size_t)DM * DFF * 2 <= WS_XB, "ws map 1");
static_assert(WS_PROJ + (size_t)S_ * NPROJ * 2 <= WS_END && WS_ACT + (size_t)S_ * DFF * 2 <= WS_END && WS_MASK + 8 * MiB <= WS_WT_A, "ws map 2");

#define GAS __attribute__((address_space(1)))
#define LAS __attribute__((address_space(3)))
typedef unsigned short bf16;
typedef unsigned v4u __attribute__((ext_vector_type(4)));
typedef float f32x4 __attribute__((ext_vector_type(4)));
__device__ __forceinline__ unsigned f2bf(float f) { unsigned u = __builtin_bit_cast(unsigned, f); return (u + 0x7fffu + ((u >> 16) & 1u)) >> 16; }
__device__ __forceinline__ unsigned pk2(float lo, float hi) { return f2bf(lo) | (f2bf(hi) << 16); }
__device__ __forceinline__ float bf2f(bf16 v) { return __uint_as_float((unsigned)v << 16); }
__device__ __forceinline__ float wave_sum(float v) {
#pragma unroll
    for (int o = 1; o < 64; o <<= 1) v += __shfl_xor(v, o);
    return v;
}
__device__ __forceinline__ float wave_max(float v) {
#pragma unroll
    for (int o = 1; o < 64; o <<= 1) v = fmaxf(v, __shfl_xor(v, o));
    return v;
}

__device__ __forceinline__ void transpose_item(const float* W, int Nsrc, int K, bf16* WT, int n0, int k0, int srccol0, int nvalid, float* scr, int lane) {
#pragma unroll 8
    for (int i = 0; i < 32; ++i) { const int kk = 2 * i + (lane >> 5); const int c = lane & 31;
        scr[kk * 33 + c] = (c < nvalid) ? W[(size_t)(k0 + kk) * Nsrc + srccol0 + c] : 0.f; }
    __builtin_amdgcn_s_waitcnt(0xc07f); asm volatile("" ::: "memory");
    const int c = lane & 7;
#pragma unroll
    for (int j = 0; j < 4; ++j) { const int n = (lane >> 3) + 8 * j; const float* s = scr + (8 * c) * 33 + n;
        v4u o; o.x = pk2(s[0 * 33], s[1 * 33]); o.y = pk2(s[2 * 33], s[3 * 33]); o.z = pk2(s[4 * 33], s[5 * 33]); o.w = pk2(s[6 * 33], s[7 * 33]);
        *(v4u*)(WT + (size_t)(n0 + n) * K + k0 + 8 * c) = o; }
    __builtin_amdgcn_s_waitcnt(0xc07f); asm volatile("" ::: "memory");
}
struct ProArgs { const float *x, *w_in, *w_a, *w_b, *w_out, *w_gate, *w_up, *w_down; unsigned char* ws; };
__device__ __forceinline__ void prologue_body(const ProArgs& a, float* scr  , int gw, int NGW, int lane) {
    bf16* wt_in = (bf16*)(a.ws + WS_WT_IN); bf16* wt_a = (bf16*)(a.ws + WS_WT_A); bf16* wt_b = (bf16*)(a.ws + WS_WT_B); bf16* wt_out = (bf16*)(a.ws + WS_WT_OUT);
    bf16* wt_gu = (bf16*)(a.ws + WS_WT_GU); bf16* wt_down = (bf16*)(a.ws + WS_WT_DOWN); bf16* xb = (bf16*)(a.ws + WS_XB);
    constexpr int I_IN = (DM / 64) * (NPROJ / 32), I_A = (1024 / 64) * (DM / 32), I_B = (512 / 64) * (DM / 32), I_OUT = (DM / 64) * (DM / 32), I_GU = (DM / 64) * (NGU / 32), I_DN = (DFF / 64) * (DM / 32);
    constexpr int NITEMS = I_IN + I_A + I_B + I_OUT + I_GU + I_DN;
    for (int it = gw; it < NITEMS; it += NGW) {
        int r = it;
        if (r < I_IN) { const int nb = r % (NPROJ / 32), kb = r / (NPROJ / 32), n0 = nb * 32;
            int src, nv = 32;
            if (n0 < 4096) src = n0; else if (n0 < 12800) src = n0 + 80; else if (n0 < 12880) { src = n0 - 12800 + 4096; nv = (12880 - n0) < 32 ? (12880 - n0) : 32; } else { src = 0; nv = 0; }
            transpose_item(a.w_in, IN_W, DM, wt_in, n0, kb * 64, src, nv, scr, lane); continue; }
        r -= I_IN;
        if (r < I_A) { const int nb = r % (DM / 32), kb = r / (DM / 32); transpose_item(a.w_a, DM, 1024, wt_a, nb * 32, kb * 64, nb * 32, 32, scr, lane); continue; }
        r -= I_A;
        if (r < I_B) { const int nb = r % (DM / 32), kb = r / (DM / 32); transpose_item(a.w_b, DM, 512, wt_b, nb * 32, kb * 64, nb * 32, 32, scr, lane); continue; }
        r -= I_B;
        if (r < I_OUT) { const int nb = r % (DM / 32), kb = r / (DM / 32); transpose_item(a.w_out, DM, DM, wt_out, nb * 32, kb * 64, nb * 32, 32, scr, lane); continue; }
        r -= I_OUT;
        if (r < I_GU) { const int nb = r % (NGU / 32), kb = r / (NGU / 32), n0 = nb * 32; const int half = (n0 >> 7) & 1, j = n0 >> 8, i = n0 & 127;
            transpose_item(half ? a.w_up : a.w_gate, DFF, DM, wt_gu, n0, kb * 64, 128 * j + i, 32, scr, lane); continue; }
        r -= I_GU;
        { const int nb = r % (DM / 32), kb = r / (DM / 32); transpose_item(a.w_down, DM, DFF, wt_down, nb * 32, kb * 64, nb * 32, 32, scr, lane); }
    }
    for (int m = gw; m < S_; m += NGW) {
        const f32x4* xr = (const f32x4*)(a.x + (size_t)m * DM) + lane; unsigned long long* o8 = (unsigned long long*)(xb + (size_t)m * DM) + lane;
#pragma unroll
        for (int j = 0; j < 8; ++j) { const f32x4 v = xr[64 * j]; o8[64 * j] = (unsigned long long)pk2(v.x, v.y) | ((unsigned long long)pk2(v.z, v.w) << 32); }
    }
}
__device__ __forceinline__ void ln_row(const float* Y, const float* g, const float* b, float* outf, bf16* outb, int row, int lane) {
    const f32x4* yr = (const f32x4*)(Y + (size_t)row * DM) + lane;
    f32x4 v[8]; float s = 0.f;
#pragma unroll
    for (int j = 0; j < 8; ++j) { v[j] = yr[64 * j]; s += (v[j].x + v[j].y) + (v[j].z + v[j].w); }
    const float mean = wave_sum(s) * (1.f / DM); float s2 = 0.f;
#pragma unroll
    for (int j = 0; j < 8; ++j) { v[j] = v[j] - mean; s2 += (v[j].x * v[j].x + v[j].y * v[j].y) + (v[j].z * v[j].z + v[j].w * v[j].w); }
    const float rstd = 1.f / sqrtf(wave_sum(s2) * (1.f / DM) + LN_EPS);
#pragma unroll
    for (int j = 0; j < 8; ++j) { const f32x4 gg = ((const f32x4*)g)[lane + 64 * j], bb = ((const f32x4*)b)[lane + 64 * j]; const f32x4 o = v[j] * rstd * gg + bb;
        ((f32x4*)(outf + (size_t)row * DM))[lane + 64 * j] = o;
        if (outb) ((unsigned long long*)(outb + (size_t)row * DM))[lane + 64 * j] = (unsigned long long)pk2(o.x, o.y) | ((unsigned long long)pk2(o.z, o.w) << 32); }
}

__device__ __forceinline__ unsigned ord_key(float f) { unsigned u = __float_as_uint(f); return (u & 0x80000000u) ? ~u : (u | 0x80000000u); }
template <int NT> __device__ __forceinline__ unsigned block_exscan(unsigned v, unsigned* sh, unsigned* tot) {
    const int lane = threadIdx.x & 63, w = threadIdx.x >> 6;
    unsigned inc = v;
#pragma unroll
    for (int o = 1; o < 64; o <<= 1) { unsigned t = __shfl_up(inc, o); if (lane >= o) inc += t; }
    __syncthreads();
    if (lane == 63) sh[w] = inc;
    __syncthreads();
    unsigned base = 0, total = 0;
#pragma unroll
    for (int i = 0; i < NT / 64; ++i) { const unsigned s = sh[i]; if (i < w) base += s; total += s; }
    *tot = total;
    return base + inc - v;
}
constexpr int NTK_LDS_BYTES = (8192 + 1024 + 16 + 256 + 8 + 8) * 4;
template <int NT> __device__ __forceinline__ void naive_topk_query(int t, const bf16* proj, int* sel_idx, int* sel_cnt, float* ldsf) {
    float* sc = ldsf; float* qs = sc + 8192; float* wsh = qs + 1024; unsigned* hist = (unsigned*)(wsh + 16); unsigned* shs = hist + 256; unsigned* shp = shs + 8;
    const int tid = threadIdx.x; const int n = t + 1;
    const bf16* prow = proj + (size_t)t * NPROJ;
    __syncthreads();
    for (int i = tid; i < 1024; i += NT) qs[i] = bf2f(prow[C_IQ + i]);
    if (tid < 16) wsh[tid] = bf2f(prow[C_IW + tid]) * 0.25f;
    __syncthreads();
    for (int s = tid; s < n; s += NT) {
        const bf16* kr = proj + (size_t)s * NPROJ + C_IK; float kf[64];
#pragma unroll
        for (int i = 0; i < 8; ++i) { const v4u w = ((const v4u*)kr)[i];
            kf[8 * i + 0] = __uint_as_float(w.x << 16); kf[8 * i + 1] = __uint_as_float(w.x & 0xffff0000u); kf[8 * i + 2] = __uint_as_float(w.y << 16); kf[8 * i + 3] = __uint_as_float(w.y & 0xffff0000u);
            kf[8 * i + 4] = __uint_as_float(w.z << 16); kf[8 * i + 5] = __uint_as_float(w.z & 0xffff0000u); kf[8 * i + 6] = __uint_as_float(w.w << 16); kf[8 * i + 7] = __uint_as_float(w.w & 0xffff0000u); }
        float score = 0.f;
        for (int h = 0; h < 16; ++h) { float d = 0.f;
#pragma unroll
            for (int i = 0; i < 64; ++i) d = fmaf(qs[h * 64 + i], kf[i], d);
            score = fmaf(wsh[h], fmaxf(d * 0.125f, 0.f), score); }
        sc[s] = score;
    }
    __syncthreads();
    int* out = sel_idx + (size_t)t * TOPK;
    if (n <= TOPK) { if (tid < TOPK) out[tid] = tid < n ? tid : -1; if (tid == 0) sel_cnt[t] = n; return; }
    if (tid == 0) { shp[0] = 0u; shp[1] = TOPK; }
    unsigned maskbits = 0u;
    for (int round = 0; round < 4; ++round) {
        const int shift = 24 - 8 * round;
        if (tid < 256) hist[tid] = 0u;
        __syncthreads();
        const unsigned prefix = shp[0];
        for (int s = tid; s < n; s += NT) { const unsigned k = ord_key(sc[s]); if ((k & maskbits) == prefix) atomicAdd(&hist[(k >> shift) & 255u], 1u); }
        __syncthreads();
        if (tid == 0) { unsigned r = shp[1], cum = 0; int b = 255; for (; b > 0; --b) { if (cum + hist[b] >= r) break; cum += hist[b]; } shp[1] = r - cum; shp[0] = prefix | ((unsigned)b << shift); }
        maskbits |= 255u << shift;
        __syncthreads();
    }
    const unsigned tau = shp[0]; const unsigned rt = shp[1];
    constexpr int CH = S_ / NT;
    const int s0 = tid * CH;
    unsigned nt = 0;
    for (int i = 0; i < CH; ++i) { const int s = s0 + i; if (s < n && ord_key(sc[s]) == tau) ++nt; }
    unsigned tot; unsigned tr = block_exscan<NT>(nt, shs, &tot);
    unsigned ns = 0; unsigned flags = 0;
    for (int i = 0; i < CH; ++i) { const int s = s0 + i; if (s < n) { const unsigned k = ord_key(sc[s]); bool sel = k > tau; if (k == tau) { sel = tr < rt; ++tr; } if (sel) { flags |= 1u << i; ++ns; } } }
    unsigned sbase = block_exscan<NT>(ns, shs, &tot);
    for (int i = 0; i < CH; ++i) if (flags & (1u << i)) out[sbase++] = s0 + i;
    if (tid == 0) sel_cnt[t] = (int)tot;
}
constexpr int NAA_LDS_WAVE = (128 + 256 + 256) * 4;
__device__ __forceinline__ void naive_attn_a_wave(int t, int h, const bf16* proj, const int* sel_idx, const int* sel_cnt, bf16* oa, float* ldsw, int lane) {
    float* q = ldsw; float* pw = q + 128; int* sel = (int*)(pw + 256);
    const bf16* prow = proj + (size_t)t * NPROJ;
    for (int i = lane; i < 128; i += 64) q[i] = bf2f(prow[C_AQ + h * 128 + i]);
    for (int i = lane; i < 256; i += 64) sel[i] = sel_idx[(size_t)t * TOPK + i];
    const int cnt = sel_cnt[t];
    __builtin_amdgcn_s_waitcnt(0xc07f); asm volatile("" ::: "memory");
    const float slope = exp2f(-0.4f * (float)(13 + h));
    float lg[4]; float mx = -INFINITY;
#pragma unroll
    for (int i = 0; i < 4; ++i) { const int k = lane + 64 * i; lg[i] = -INFINITY;
        if (k < cnt) { const int s = sel[k]; const v4u* kr = (const v4u*)(proj + (size_t)s * NPROJ + C_AK + h * 128); float d = 0.f;
            for (int c = 0; c < 16; ++c) { const v4u wv = kr[c];
                d = fmaf(q[8 * c + 0], __uint_as_float(wv.x << 16), d); d = fmaf(q[8 * c + 1], __uint_as_float(wv.x & 0xffff0000u), d);
                d = fmaf(q[8 * c + 2], __uint_as_float(wv.y << 16), d); d = fmaf(q[8 * c + 3], __uint_as_float(wv.y & 0xffff0000u), d);
                d = fmaf(q[8 * c + 4], __uint_as_float(wv.z << 16), d); d = fmaf(q[8 * c + 5], __uint_as_float(wv.z & 0xffff0000u), d);
                d = fmaf(q[8 * c + 6], __uint_as_float(wv.w << 16), d); d = fmaf(q[8 * c + 7], __uint_as_float(wv.w & 0xffff0000u), d); }
            lg[i] = d * 0.08838834764831845f - slope * (float)(t - s); }
        mx = fmaxf(mx, lg[i]); }
    mx = wave_max(mx); float sum = 0.f;
#pragma unroll
    for (int i = 0; i < 4; ++i) { lg[i] = (lane + 64 * i < cnt) ? __expf(lg[i] - mx) : 0.f; sum += lg[i]; }
    sum = wave_sum(sum); const float inv = 1.f / sum;
#pragma unroll
    for (int i = 0; i < 4; ++i) pw[lane + 64 * i] = lg[i] * inv;
    __builtin_amdgcn_s_waitcnt(0xc07f); asm volatile("" ::: "memory");
    float o0 = 0.f, o1 = 0.f;
    for (int k = 0; k < cnt; ++k) { const int s = sel[k]; const unsigned vv = *(const unsigned*)(proj + (size_t)s * NPROJ + C_AV + h * 128 + 2 * lane); const float p = pw[k];
        o0 = fmaf(p, __uint_as_float(vv << 16), o0); o1 = fmaf(p, __uint_as_float(vv & 0xffff0000u), o1); }
    *(unsigned*)(oa + (size_t)t * 1024 + h * 128 + 2 * lane) = pk2(o0, o1);
    __builtin_amdgcn_s_waitcnt(0xc07f); asm volatile("" ::: "memory");
}
constexpr int NAB_LDS_WAVE = (384 + 388) * 4;
__device__ __forceinline__ void naive_attn_b_wave(int t, int j, const bf16* proj, bf16* ob, float* ldsw, int lane) {
    float* qsh = ldsw; float* pw = qsh + 384;
    const bf16* prow = proj + (size_t)t * NPROJ;
    for (int g = 0; g < 3; ++g) for (int i = lane; i < 128; i += 64) qsh[g * 128 + i] = bf2f(prow[C_BQ + (4 * g + j) * 128 + i]);
    __builtin_amdgcn_s_waitcnt(0xc07f); asm volatile("" ::: "memory");
    float mx = -INFINITY;
    for (int g = 0; g < 3; ++g) { const int d = g == 0 ? 1 : (g == 1 ? 4 : 16); const int m = t / d; const int nk = (m < 128 ? m : 128) + 1; const int head = 4 * g + j;
        const float slope = exp2f(-0.4f * (float)(head + 1)); const float* q = qsh + g * 128;
        for (int i = lane; i < 129; i += 64) { float l = -INFINITY;
            if (i < nk) { const int s = t - i * d; const v4u* kr = (const v4u*)(proj + (size_t)s * NPROJ + C_BK + head * 128); float dd = 0.f;
                for (int c = 0; c < 16; ++c) { const v4u wv = kr[c];
                    dd = fmaf(q[8 * c + 0], __uint_as_float(wv.x << 16), dd); dd = fmaf(q[8 * c + 1], __uint_as_float(wv.x & 0xffff0000u), dd);
                    dd = fmaf(q[8 * c + 2], __uint_as_float(wv.y << 16), dd); dd = fmaf(q[8 * c + 3], __uint_as_float(wv.y & 0xffff0000u), dd);
                    dd = fmaf(q[8 * c + 4], __uint_as_float(wv.z << 16), dd); dd = fmaf(q[8 * c + 5], __uint_as_float(wv.z & 0xffff0000u), dd);
                    dd = fmaf(q[8 * c + 6], __uint_as_float(wv.w << 16), dd); dd = fmaf(q[8 * c + 7], __uint_as_float(wv.w & 0xffff0000u), dd); }
                l = dd * 0.08838834764831845f - slope * (float)(i * d); }
            pw[g * 129 + i] = l; mx = fmaxf(mx, l); } }
    mx = wave_max(mx);
    __builtin_amdgcn_s_waitcnt(0xc07f); asm volatile("" ::: "memory");
    float sum = 0.f;
    for (int i = lane; i < 387; i += 64) { const float p = __expf(pw[i] - mx); pw[i] = p; sum += p; }
    sum = wave_sum(sum); const float inv = 1.f / sum;
    __builtin_amdgcn_s_waitcnt(0xc07f); asm volatile("" ::: "memory");
    float o0 = 0.f, o1 = 0.f;
    for (int g = 0; g < 3; ++g) { const int d = g == 0 ? 1 : (g == 1 ? 4 : 16); const int m = t / d; const int nk = (m < 128 ? m : 128) + 1; const int head = 4 * g + j;
        for (int i = 0; i < nk; ++i) { const int s = t - i * d; const unsigned vv = *(const unsigned*)(proj + (size_t)s * NPROJ + C_BV + head * 128 + 2 * lane); const float p = pw[g * 129 + i];
            o0 = fmaf(p, __uint_as_float(vv << 16), o0); o1 = fmaf(p, __uint_as_float(vv & 0xffff0000u), o1); } }
    *(unsigned*)(ob + (size_t)t * 512 + j * 128 + 2 * lane) = pk2(o0 * inv, o1 * inv);
    __builtin_amdgcn_s_waitcnt(0xc07f); asm volatile("" ::: "memory");
}

constexpr int NWAVES = 8;
constexpr int RING_BYTES = 131072;
constexpr int LDSCTL_OFF = RING_BYTES, MISC_OFF = LDSCTL_OFF + 320;
constexpr int LDS_BYTES = 147456;
constexpr int CW_TMO = 0, CW_BAR = 4096;
typedef GAS unsigned gu32;
#define RLX_AGENT __ATOMIC_RELAXED, __HIP_MEMORY_SCOPE_AGENT
#define XB_TMO      128
#define XB_XCNT(j)  (256  + 64 * (j))
#define XB_XSUB(j)  (1280 + 64 * (j))
#define XB_XGEN(j)  (2304 + 64 * (j))
#define XB_TOP      3328
#define XB_TOPGEN   3392
#define XCD_BAR_WORDS 3456
#define XB_SPIN_CAP (1u << 22)

__device__ __forceinline__ unsigned xb_ld(unsigned* p)              { return __hip_atomic_load(p, __ATOMIC_RELAXED, __HIP_MEMORY_SCOPE_AGENT); }
__device__ __forceinline__ unsigned xb_add(unsigned* p, unsigned v) { return __hip_atomic_fetch_add(p, v, __ATOMIC_RELAXED, __HIP_MEMORY_SCOPE_AGENT); }
__device__ __forceinline__ unsigned xb_xcc_id() { return (unsigned)__builtin_amdgcn_s_getreg((3 << 11) | 20) & 0xFu; }
#define XB_SPIN(cond, bar) do { unsigned _sp = 0; while (cond) { __builtin_amdgcn_s_sleep(1); \
    if ((++_sp & 255u) == 0u) { if (xb_ld(&(bar)[XB_TMO])) break; if (_sp > XB_SPIN_CAP) { atomicAdd(&(bar)[XB_TMO], 1u); break; } } } } while (0)

struct XcdBarrier {
    unsigned* bar; unsigned x;
    volatile LAS unsigned* st;
};

__device__ __forceinline__ XcdBarrier xcd_barrier_post(unsigned* bar, volatile LAS unsigned* st) {
    XcdBarrier b; b.bar = bar; b.x = xb_xcc_id(); b.st = st;
    if (threadIdx.x == 0) (void)xb_add(&bar[XB_XCNT(b.x)], 1u);
    return b;
}
__device__ __forceinline__ void xcd_barrier_complete(unsigned* bar, unsigned x, unsigned& nloc, unsigned& nx) {
    const unsigned G = gridDim.x * gridDim.y * gridDim.z;
    unsigned sum, cnt, mine, sp = 0u;
    for (;;) {
        sum = 0u; cnt = 0u; mine = 0u;
#pragma unroll
        for (unsigned j = 0; j < 16; ++j) { const unsigned c = xb_ld(&bar[XB_XCNT(j)]); sum += c; cnt += (c > 0u) ? 1u : 0u; mine = (j == x) ? c : mine; }
        if (sum == G) break;
        __builtin_amdgcn_s_sleep(1);
        if ((++sp & 255u) == 0u) { if (xb_ld(&bar[XB_TMO])) break; if (sp > XB_SPIN_CAP) { atomicAdd(&bar[XB_TMO], 1u); break; } }
    }
    nloc = mine > 0u ? mine : 1u; nx = cnt > 0u ? cnt : 1u;
}

__device__ __forceinline__ void xcd_barrier(const XcdBarrier& b) {
    asm volatile("s_waitcnt vmcnt(0)" ::: "memory");
    __syncthreads();
    if (threadIdx.x == 0) {
        unsigned* bar = b.bar;
        __builtin_amdgcn_s_waitcnt(0);
        unsigned nloc = b.st[0], nx = b.st[1];
        if (nloc == 0u) { xcd_barrier_complete(bar, b.x, nloc, nx); b.st[0] = nloc; b.st[1] = nx; }
        const unsigned old = xb_add(&bar[XB_XSUB(b.x)], 1u);
        const unsigned gen = old / nloc;
        if (old + 1u == (gen + 1u) * nloc) {
            __builtin_amdgcn_fence(__ATOMIC_RELEASE, "agent");
            asm volatile("s_waitcnt vmcnt(0)" ::: "memory");
            const unsigned og = xb_add(&bar[XB_TOP], 1u);
            const unsigned tg = og / nx;
            if (og + 1u == (tg + 1u) * nx) xb_add(&bar[XB_TOPGEN], 1u);
            else XB_SPIN(xb_ld(&bar[XB_TOPGEN]) == tg, bar);
            __builtin_amdgcn_fence(__ATOMIC_ACQUIRE, "agent");
            xb_add(&bar[XB_XGEN(b.x)], 1u);
            asm volatile("s_waitcnt vmcnt(0)" ::: "memory");
        } else {
            XB_SPIN(xb_ld(&bar[XB_XGEN(b.x)]) == gen, bar);
            __builtin_amdgcn_fence(__ATOMIC_ACQUIRE, "agent");
            asm volatile("s_waitcnt vmcnt(0)" ::: "memory");
        }
    }
    __syncthreads();
}

enum { P_PRO = 0, P_PROJ, P_TOPK, P_ATTN, P_MERGE, P_WOUT, P_LN1, P_GU, P_DOWN, P_LN2, NPH };
struct Args { const float* in[12]; float* out; unsigned char* ws; int ph_lo, ph_hi, li, pad; };
__global__ void __launch_bounds__(NWAVES * 64, 2) mega_kernel(Args args) {
    extern __shared__ __attribute__((aligned(16))) unsigned char lds_raw[];
    LAS unsigned char* lds = (LAS unsigned char*)lds_raw;
    volatile LAS unsigned* MISC = (volatile LAS unsigned*)(lds + MISC_OFF);
    const int tid = threadIdx.x, lane = tid & 63, wave = __builtin_amdgcn_readfirstlane(tid >> 6);
    const int G = gridDim.x, bx = blockIdx.x; const int vcu = (G % 8 == 0) ? (bx % 8) * (G / 8) + bx / 8 : bx;
    unsigned char* ws = args.ws; unsigned* ctl = (unsigned*)(ws + WS_CTL);
    for (int u = tid; u < (LDS_BYTES - LDSCTL_OFF) / 4; u += NWAVES * 64) ((LAS unsigned*)(lds + LDSCTL_OFF))[u] = 0u;
    __syncthreads();
    XcdBarrier bar = xcd_barrier_post(ctl + CW_BAR + args.li * XCD_BAR_WORDS, MISC + 8);
    const int lo = args.ph_lo, hi = args.ph_hi;
#define IN(k) (lo <= (k) && (k) < hi)
#define SEAM(k) do { if (IN(k) && IN((k) + 1)) xcd_barrier(bar); } while (0)
    using pg8::bf16_t;
    const float* x = args.in[0]; float* out = args.out;
    const bf16* proj = (const bf16*)(ws + WS_PROJ);

    if (IN(P_PRO)) {
        ProArgs pa{x, args.in[1], args.in[2], args.in[3], args.in[4], args.in[7], args.in[8], args.in[9], ws};
        prologue_body(pa, (float*)(lds_raw + wave * 16384), vcu * NWAVES + wave, G * NWAVES, lane);
    }
    SEAM(P_PRO);
    if (IN(P_PROJ)) {
        pg8::Gemm g{(const bf16_t*)(ws + WS_XB), (const bf16_t*)(ws + WS_WT_IN), S_, NPROJ, DM}; pg8::StaticOrder S; S.init(S_, NPROJ, G, bx);
        pg8::EpiProj E{(bf16_t*)(ws + WS_PROJ), NPROJ, C_GA, C_IK};
        pg8::gemm_phase<pg8::EpiProj, pg8::StaticOrder, PG8_ALIGN, PG8_SP2>(lds, g, S, E);
    }
    SEAM(P_PROJ);
    if (IN(P_TOPK)) {
        for (int t = S_ - 1 - bx; t >= 0; t -= G) naive_topk_query<NWAVES * 64>(t, proj, (int*)(ws + WS_SELIDX), (int*)(ws + WS_SELCNT), (float*)lds_raw);
        __syncthreads();
    }
    SEAM(P_TOPK);
    if (IN(P_ATTN)) {
        for (int t = S_ - 1 - bx; t >= 0; t -= G) naive_attn_a_wave(t, wave, proj, (const int*)(ws + WS_SELIDX), (const int*)(ws + WS_SELCNT), (bf16*)(ws + WS_OA), (float*)(lds_raw + wave * 4096), lane);
        for (int tp = bx; tp < S_ / 2; tp += G) naive_attn_b_wave(2 * tp + (wave >> 2), wave & 3, proj, (bf16*)(ws + WS_OB), (float*)(lds_raw + wave * 4096), lane);
    }
    SEAM(P_ATTN);
    if (IN(P_MERGE)) {
        { pg8::Gemm g{(const bf16_t*)(ws + WS_OA), (const bf16_t*)(ws + WS_WT_A), S_, DM, 1024}; pg8::StaticOrder S; S.init(S_, DM, G, bx);
          pg8::EpiMerge<1> E{(const bf16_t*)(ws + WS_PROJ), NPROJ, C_GA, out, DM, nullptr, 0};
          pg8::gemm_phase<pg8::EpiMerge<1>, pg8::StaticOrder, PG8_ALIGN, PG8_SP2>(lds, g, S, E); }
        { pg8::Gemm g{(const bf16_t*)(ws + WS_OB), (const bf16_t*)(ws + WS_WT_B), S_, DM, 512}; pg8::StaticOrder S; S.init(S_, DM, G, bx);
          pg8::EpiMerge<2> E{(const bf16_t*)(ws + WS_PROJ), NPROJ, C_GB, out, DM, (bf16_t*)(ws + WS_MERGED), DM};
          pg8::gemm_phase<pg8::EpiMerge<2>, pg8::StaticOrder, PG8_ALIGN, PG8_SP2>(lds, g, S, E); }
    }
    SEAM(P_MERGE);
    if (IN(P_WOUT)) {
        pg8::Gemm g{(const bf16_t*)(ws + WS_MERGED), (const bf16_t*)(ws + WS_WT_OUT), S_, DM, DM}; pg8::StaticOrder S; S.init(S_, DM, G, bx);
        pg8::EpiRes E{x, (float*)(ws + WS_H), DM, ALPHA};
        pg8::gemm_phase<pg8::EpiRes, pg8::StaticOrder, PG8_ALIGN, PG8_SP2>(lds, g, S, E);
    }
    SEAM(P_WOUT);
    if (IN(P_LN1)) { for (int row = vcu * NWAVES + wave; row < S_; row += G * NWAVES) ln_row((const float*)(ws + WS_H), args.in[5], args.in[6], (float*)(ws + WS_H), (bf16*)(ws + WS_HB), row, lane); }
    SEAM(P_LN1);
    if (IN(P_GU)) {
        pg8::Gemm g{(const bf16_t*)(ws + WS_HB), (const bf16_t*)(ws + WS_WT_GU), S_, NGU, DM}; pg8::StaticOrder S; S.init(S_, NGU, G, bx);
        pg8::EpiSwiGLU E{(bf16_t*)(ws + WS_ACT), DFF};
        pg8::gemm_phase<pg8::EpiSwiGLU, pg8::StaticOrder, PG8_ALIGN, PG8_SP2>(lds, g, S, E);
    }
    SEAM(P_GU);
    if (IN(P_DOWN)) {
        pg8::Gemm g{(const bf16_t*)(ws + WS_ACT), (const bf16_t*)(ws + WS_WT_DOWN), S_, DM, DFF}; pg8::StaticOrder S; S.init(S_, DM, G, bx);
        pg8::EpiRes E{(const float*)(ws + WS_H), out, DM, ALPHA};
        pg8::gemm_phase<pg8::EpiRes, pg8::StaticOrder, PG8_ALIGN, PG8_SP2>(lds, g, S, E);
    }
    SEAM(P_DOWN);
    if (IN(P_LN2)) { for (int row = vcu * NWAVES + wave; row < S_; row += G * NWAVES) ln_row(out, args.in[10], args.in[11], out, (bf16*)nullptr, row, lane); }
#undef IN
#undef SEAM
}

#ifndef MK_CUTS
#define MK_CUTS {0, NPH}
#endif
extern "C" void kernel_launch(void* const* d_in, const int* in_sizes, int n_in, void* d_out, int out_size, void* d_ws, size_t ws_size, hipStream_t stream) {
    static int grid = 0;
    if (grid == 0) {
        if (n_in != 12 || in_sizes[0] != S_ * DM || out_size != S_ * DM || ws_size < WS_END) { fprintf(stderr, "kernel_launch: unexpected shapes / workspace (n_in %d, in0 %d, out %d, ws %zu)\n", n_in, n_in > 0 ? in_sizes[0] : -1, out_size, ws_size); grid = -1; return; }
        int dev = 0, cus = 0, per_cu = 0;
        if (hipGetDevice(&dev) != hipSuccess || hipDeviceGetAttribute(&cus, hipDeviceAttributeMultiprocessorCount, dev) != hipSuccess) { grid = -1; return; }
        if (hipFuncSetAttribute((const void*)mega_kernel, hipFuncAttributeMaxDynamicSharedMemorySize, LDS_BYTES) != hipSuccess) { fprintf(stderr, "kernel_launch: hipFuncSetAttribute failed\n"); grid = -1; return; }
        if (hipOccupancyMaxActiveBlocksPerMultiprocessor(&per_cu, (const void*)mega_kernel, NWAVES * 64, LDS_BYTES) != hipSuccess || per_cu < 1) { fprintf(stderr, "kernel_launch: occupancy query says %d workgroups per CU\n", per_cu); (void)hipGetLastError(); grid = -1; return; }
        grid = cus;
    }
    if (grid < 0) return;
    if (hipMemsetAsync((char*)d_ws + WS_CTL, 0, CTL_ZERO_BYTES, stream) != hipSuccess) return;
    Args a{};
    for (int i = 0; i < 12; ++i) a.in[i] = (const float*)d_in[i];
    a.out = (float*)d_out; a.ws = (unsigned char*)d_ws;
    const int cuts[] = MK_CUTS; const int nl = (int)(sizeof(cuts) / sizeof(int)) - 1;
    for (int li = 0; li < nl; ++li) { a.ph_lo = cuts[li]; a.ph_hi = cuts[li + 1]; a.li = li;
        hipLaunchKernelGGL(mega_kernel, dim3(grid), dim3(NWAVES * 64), LDS_BYTES, stream, a); }
}
```

```cpp
#include <hip/hip_runtime.h>
#include <cstdio>
#include <cstdint>
#ifndef DBG_TOPK
#define DBG_TOPK 0
#endif
#define DBG_ANY (DBG_TOPK)
namespace pg8 {
#define PG8_LAS __attribute__((address_space(3)))
typedef unsigned short bf16_t;
typedef short bf16x8 __attribute__((ext_vector_type(8)));
typedef float f32x4 __attribute__((ext_vector_type(4)));
typedef unsigned u32x4 __attribute__((ext_vector_type(4)));
constexpr int BM = 256, BK = 64, HALF = 128, HTB = HALF * BK * 2  , STAGE_BYTES = 8 * HTB, NXCD = 8, WGM = 8;

__host__ __device__ __forceinline__ int lds_byte(int r, int c) { const int st = (r >> 4) * 2 + (c >> 5), rr = r & 15, cc = c & 31, ob = rr * 64 + cc * 2; return st * 1024 + (ob ^ (((ob >> 9) & 1) << 5)); }
__host__ __device__ __forceinline__ void stage_rc(int b, int& R, int& C) { const int st = b / 1024, sb = b % 1024, swz = sb ^ (((sb >> 9) & 1) << 5); R = (st >> 1) * 16 + swz / 64; C = (st & 1) * 32 + (swz % 64) / 2; }
__host__ __device__ __forceinline__ int perm32(int rho) { const int n = rho >> 4, i = rho & 15; return 8 * (i >> 2) + 4 * n + (i & 3); }

struct Unit { int pm, pn; };
struct Gemm { const bf16_t* A; const bf16_t* Bt; int M, N, K; };

struct StaticOrder {
    int nM, nN, nwg, G, c;
    __host__ __device__ void init(int M, int N, int G_, int c_) { nM = M / BM; nN = N / BM; nwg = nM * nN; G = G_; c = c_; }
    __host__ __device__ bool next(int i, Unit& u) const {
        const long L = (long)i * G + c; if (L >= nwg) return false;
        int wgid = (int)L; { const int q = nwg / NXCD, r = nwg % NXCD, xcd = wgid % NXCD, off = wgid / NXCD; wgid = (xcd < r ? xcd * (q + 1) : r * (q + 1) + (xcd - r) * q) + off; }
        const int nig = WGM * nN, gid = wgid / nig, fm = gid * WGM, gsz = (nM - fm) < WGM ? (nM - fm) : WGM;
        u.pm = fm + ((wgid % nig) % gsz); u.pn = (wgid % nig) / gsz; return true;
    }
    __device__ __forceinline__ void a_ready(const Unit&) const {}
    __device__ __forceinline__ void done(const Unit&) const {}
};

__device__ __forceinline__ unsigned cvt_pk_bf16(float lo, float hi) { unsigned r; asm volatile("v_cvt_pk_bf16_f32 %0, %1, %2" : "=v"(r) : "v"(lo), "v"(hi)); return r; }
__device__ __forceinline__ float bf_lo(unsigned w) { return __uint_as_float(w << 16); }
__device__ __forceinline__ float bf_hi(unsigned w) { return __uint_as_float(w & 0xffff0000u); }
__device__ __forceinline__ float sigmoidf_fast(float v) { return __builtin_amdgcn_rcpf(1.0f + __builtin_amdgcn_exp2f(-1.4426950408889634f * v)); }

struct EpiProj {
    static constexpr bool PERM = true, AFTER_DRAIN = false;
    bf16_t* O; int ldc; int sig_lo, sig_hi;
    __device__ __forceinline__ void operator()(const f32x4 (&acc)[2][2][4][2], const Unit& u, int wr, int wc, int fr, int fq) const {
        const int row0 = u.pm * BM + wr * 64 + fr; const int colt = u.pn * BM; const bool sg = colt >= sig_lo && colt < sig_hi;
        const int col0 = colt + wc * 32 + 8 * fq;
#pragma unroll
        for (int ai = 0; ai < 2; ++ai)
#pragma unroll
            for (int m = 0; m < 4; ++m) { bf16_t* rowp = O + (size_t)(row0 + ai * HALF + m * 16) * ldc + col0;
#pragma unroll
                for (int bj = 0; bj < 2; ++bj) { f32x4 v0 = acc[ai][bj][m][0], v1 = acc[ai][bj][m][1];
                    if (sg) {
#pragma unroll
                        for (int e = 0; e < 4; ++e) { v0[e] = sigmoidf_fast(v0[e]); v1[e] = sigmoidf_fast(v1[e]); } }
                    u32x4 w; w.x = cvt_pk_bf16(v0[0], v0[1]); w.y = cvt_pk_bf16(v0[2], v0[3]); w.z = cvt_pk_bf16(v1[0], v1[1]); w.w = cvt_pk_bf16(v1[2], v1[3]);
                    *(u32x4*)(rowp + bj * HALF) = w; } }
    }
};
template <int PART> struct EpiMerge {
    static constexpr bool PERM = true, AFTER_DRAIN = false;
    const bf16_t* G; int ldg; int gcol; float* T; int ldt; bf16_t* O; int ldo;
    __device__ __forceinline__ void operator()(const f32x4 (&acc)[2][2][4][2], const Unit& u, int wr, int wc, int fr, int fq) const {
        const int row0 = u.pm * BM + wr * 64 + fr; const int col0 = u.pn * BM + wc * 32 + 8 * fq;
#pragma unroll
        for (int ai = 0; ai < 2; ++ai)
#pragma unroll
            for (int m = 0; m < 4; ++m) { const size_t row = (size_t)(row0 + ai * HALF + m * 16);
#pragma unroll
                for (int bj = 0; bj < 2; ++bj) { const int col = col0 + bj * HALF;
                    const u32x4 gw = *(const u32x4*)(G + row * ldg + gcol + col);
                    f32x4 g0 = {bf_lo(gw.x), bf_hi(gw.x), bf_lo(gw.y), bf_hi(gw.y)}, g1 = {bf_lo(gw.z), bf_hi(gw.z), bf_lo(gw.w), bf_hi(gw.w)};
                    f32x4 v0 = acc[ai][bj][m][0] * g0, v1 = acc[ai][bj][m][1] * g1;
                    float* tp = T + row * ldt + col;
                    if (PART == 1) { *(f32x4*)tp = v0; *(f32x4*)(tp + 4) = v1; }
                    else { v0 = v0 + *(const f32x4*)tp; v1 = v1 + *(const f32x4*)(tp + 4);
                        u32x4 w; w.x = cvt_pk_bf16(v0[0], v0[1]); w.y = cvt_pk_bf16(v0[2], v0[3]); w.z = cvt_pk_bf16(v1[0], v1[1]); w.w = cvt_pk_bf16(v1[2], v1[3]);
                        *(u32x4*)(O + row * ldo + col) = w; } } }
    }
};
struct EpiRes {
    static constexpr bool PERM = false, AFTER_DRAIN = false;
    const float* R; float* Y; int ldc; float alpha;
    __device__ __forceinline__ void operator()(const f32x4 (&acc)[2][2][4][2], const Unit& u, int wr, int wc, int fr, int fq) const {
        const int row0 = u.pm * BM + wr * 64 + fr, col0 = u.pn * BM + wc * 32 + 4 * fq;
#pragma unroll
        for (int ai = 0; ai < 2; ++ai)
#pragma unroll
            for (int m = 0; m < 4; ++m) { const size_t off = (size_t)(row0 + ai * HALF + m * 16) * ldc + col0;
#pragma unroll
                for (int bj = 0; bj < 2; ++bj)
#pragma unroll
                    for (int n = 0; n < 2; ++n) { const f32x4 r = *(const f32x4*)(R + off + bj * HALF + n * 16); *(f32x4*)(Y + off + bj * HALF + n * 16) = r * alpha + acc[ai][bj][m][n]; } }
    }
};
struct EpiSwiGLU {
    static constexpr bool PERM = true, AFTER_DRAIN = false;
    bf16_t* O; int ldc;
    __device__ __forceinline__ void operator()(const f32x4 (&acc)[2][2][4][2], const Unit& u, int wr, int wc, int fr, int fq) const {
        const int row0 = u.pm * BM + wr * 64 + fr; const int col0 = u.pn * HALF + wc * 32 + 8 * fq;
#pragma unroll
        for (int ai = 0; ai < 2; ++ai)
#pragma unroll
            for (int m = 0; m < 4; ++m) { f32x4 g0 = acc[ai][0][m][0], g1 = acc[ai][0][m][1]; const f32x4 u0 = acc[ai][1][m][0], u1 = acc[ai][1][m][1];
#pragma unroll
                for (int e = 0; e < 4; ++e) { g0[e] = g0[e] * sigmoidf_fast(g0[e]) * u0[e]; g1[e] = g1[e] * sigmoidf_fast(g1[e]) * u1[e]; }
                u32x4 w; w.x = cvt_pk_bf16(g0[0], g0[1]); w.y = cvt_pk_bf16(g0[2], g0[3]); w.z = cvt_pk_bf16(g1[0], g1[1]); w.w = cvt_pk_bf16(g1[2], g1[3]);
                *(u32x4*)(O + (size_t)(row0 + ai * HALF + m * 16) * ldc + col0) = w; }
    }
};

template <class Epi, class Sched, bool ALIGN_EPI = false, bool SP2 = false>
__device__ __forceinline__ void gemm_phase(PG8_LAS unsigned char* lds, const Gemm g, const Sched& S, const Epi& E) {
    const int tid = threadIdx.x, wid = __builtin_amdgcn_readfirstlane(tid >> 6), lane = tid & 63, wr = wid >> 2, wc = wid & 3, fr = lane & 15, fq = lane >> 4;
    const int K = g.K, nt = K / BK;
    unsigned voffA[2], voffB[2];
#pragma unroll
    for (int i = 0; i < 2; ++i) { int R, C; stage_rc(tid * 16 + i * 8192, R, C); const int Rb = Epi::PERM ? ((R & ~31) + perm32(R & 31)) : R;
        voffA[i] = (unsigned)(R * K + C) * 2u; voffB[i] = (unsigned)(Rb * K + C) * 2u; }
    const size_t kstep = (size_t)(BK * 2);
    const size_t hstep = (size_t)HALF * K * 2;
    const size_t tstep = 2 * hstep;
    const unsigned ldsw = (unsigned)wid * 1024u;
    const int aoff = lds_byte(wr * 64 + fr, fq * 8), boff = lds_byte(wc * 32 + fr, fq * 8);
#define PG8_SA(b, h) (((b) * 2 + (h)) * HTB)
#define PG8_SB(b, h) ((4 + (b) * 2 + (h)) * HTB)
#define PG8_STAGE(bufoff, gbase, voff) do { _Pragma("unroll") for (int _i = 0; _i < 2; ++_i) \
        __builtin_amdgcn_global_load_lds((const unsigned*)((const char*)(gbase) + (voff)[_i]), (PG8_LAS unsigned*)(lds + (bufoff) + ldsw + _i * 8192), 16, 0, 0); } while (0)
#define PG8_LDA(dst, b, h) do { _Pragma("unroll") for (int m = 0; m < 4; ++m) _Pragma("unroll") for (int k = 0; k < 2; ++k) dst[m][k] = *(const PG8_LAS bf16x8*)(lds + PG8_SA(b, h) + aoff + m * 2048 + k * 1024); } while (0)
#define PG8_LDB(dst, b, h) do { _Pragma("unroll") for (int n = 0; n < 2; ++n) _Pragma("unroll") for (int k = 0; k < 2; ++k) dst[n][k] = *(const PG8_LAS bf16x8*)(lds + PG8_SB(b, h) + boff + n * 2048 + k * 1024); } while (0)
#define PG8_MMA(ai, bj, At, Bt) do { __builtin_amdgcn_s_setprio(1); _Pragma("unroll") for (int m = 0; m < 4; ++m) _Pragma("unroll") for (int n = 0; n < 2; ++n) _Pragma("unroll") for (int k = 0; k < 2; ++k) \
        acc[ai][bj][m][n] = __builtin_amdgcn_mfma_f32_16x16x32_bf16(Bt[n][k], At[m][k], acc[ai][bj][m][n], 0, 0, 0); __builtin_amdgcn_s_setprio(0); } while (0)
#define PG8_WAIT_V(n) asm volatile("s_waitcnt vmcnt(" #n ")" ::: "memory")
#define PG8_WAIT_L(n) asm volatile("s_waitcnt lgkmcnt(" #n ")" ::: "memory")
#define PG8_BAR __builtin_amdgcn_s_barrier()
#define PG8_SCHED __builtin_amdgcn_sched_barrier(0)
    Unit cur, nxt; int ui = 0;
    if (!S.next(0, cur)) return;
    f32x4 acc[2][2][4][2];
#pragma unroll
    for (int a = 0; a < 2; ++a)
#pragma unroll
        for (int b = 0; b < 2; ++b)
#pragma unroll
            for (int m = 0; m < 4; ++m)
#pragma unroll
                for (int n = 0; n < 2; ++n) acc[a][b][m][n] = (f32x4){0.f, 0.f, 0.f, 0.f};
    bf16x8 At[4][2], B0[2][2], B1[2][2];
    const char* cA = (const char*)g.A + (size_t)cur.pm * tstep; const char* cB = (const char*)g.Bt + (size_t)cur.pn * tstep;
    S.a_ready(cur);
    if constexpr (SP2) {
        PG8_STAGE(PG8_SB(0, 0), cB, voffB); PG8_STAGE(PG8_SB(0, 1), cB + hstep, voffB); PG8_STAGE(PG8_SA(0, 0), cA, voffA); PG8_STAGE(PG8_SA(0, 1), cA + hstep, voffA);
        if (wr == 1) PG8_BAR;
        PG8_WAIT_V(2); PG8_BAR;
        PG8_STAGE(PG8_SB(1, 0), cB + kstep, voffB); PG8_STAGE(PG8_SA(1, 0), cA + kstep, voffA); PG8_STAGE(PG8_SB(1, 1), cB + hstep + kstep, voffB);
        PG8_WAIT_V(6); PG8_BAR;
    } else {
        PG8_STAGE(PG8_SB(0, 0), cB, voffB); PG8_STAGE(PG8_SA(0, 0), cA, voffA); PG8_STAGE(PG8_SB(0, 1), cB + hstep, voffB); PG8_STAGE(PG8_SA(0, 1), cA + hstep, voffA);
        if (wr == 1) PG8_BAR;
        PG8_WAIT_V(4); PG8_BAR;
        PG8_STAGE(PG8_SB(1, 0), cB + kstep, voffB); PG8_STAGE(PG8_SA(1, 0), cA + kstep, voffA); PG8_STAGE(PG8_SB(1, 1), cB + hstep + kstep, voffB);
        PG8_WAIT_V(6); PG8_BAR;
    }
    for (;;) {
        const bool has_next = S.next(ui + 1, nxt);
        const char* nA = has_next ? (const char*)g.A + (size_t)nxt.pm * tstep : cA; const char* nB = has_next ? (const char*)g.Bt + (size_t)nxt.pn * tstep : cB;
        for (int t = 0; t < nt; t += 2) {
            const bool last = (t == nt - 2);
            const char* a1 = cA + (size_t)(t + 1) * kstep;
            const char* a2 = last ? nA : cA + (size_t)(t + 2) * kstep; const char* b2 = last ? nB : cB + (size_t)(t + 2) * kstep;
            const char* a3 = a2 + kstep; const char* b3 = b2 + kstep;
            if (last && has_next) S.a_ready(nxt);
            if constexpr (SP2) {
            PG8_LDB(B0, 0, 0); PG8_LDB(B1, 0, 1); PG8_SCHED; PG8_LDA(At, 0, 0); PG8_STAGE(PG8_SA(1, 1), a1 + hstep, voffA);
            PG8_WAIT_V(8); PG8_WAIT_L(0); PG8_BAR; PG8_MMA(0, 0, At, B0); PG8_MMA(0, 1, At, B1); PG8_BAR; PG8_SCHED;
            PG8_LDA(At, 0, 1); PG8_STAGE(PG8_SB(0, 0), b2, voffB); PG8_STAGE(PG8_SB(0, 1), b2 + hstep, voffB); PG8_STAGE(PG8_SA(0, 0), a2, voffA);
            PG8_WAIT_V(8); PG8_WAIT_L(0); PG8_BAR; PG8_MMA(1, 0, At, B0); PG8_MMA(1, 1, At, B1); PG8_BAR; PG8_SCHED;
            PG8_LDB(B0, 1, 0); PG8_LDB(B1, 1, 1); PG8_SCHED; PG8_LDA(At, 1, 0); PG8_STAGE(PG8_SA(0, 1), a2 + hstep, voffA);
            PG8_WAIT_V(8); PG8_WAIT_L(0); PG8_BAR; PG8_MMA(0, 0, At, B0); PG8_MMA(0, 1, At, B1); PG8_BAR; PG8_SCHED;
            PG8_LDA(At, 1, 1); PG8_STAGE(PG8_SB(1, 0), b3, voffB); PG8_STAGE(PG8_SB(1, 1), b3 + hstep, voffB); PG8_STAGE(PG8_SA(1, 0), a3, voffA);
            PG8_WAIT_V(8); PG8_WAIT_L(0); PG8_BAR; PG8_MMA(1, 0, At, B0); PG8_MMA(1, 1, At, B1); PG8_BAR; PG8_SCHED;
            } else {
            PG8_LDB(B0, 0, 0); PG8_SCHED; PG8_LDA(At, 0, 0); PG8_STAGE(PG8_SA(1, 1), a1 + hstep, voffA);
            PG8_WAIT_L(8); PG8_BAR; PG8_WAIT_L(0); PG8_MMA(0, 0, At, B0); PG8_BAR; PG8_SCHED;
            PG8_LDB(B1, 0, 1); PG8_STAGE(PG8_SB(0, 0), b2, voffB);
            PG8_BAR; PG8_WAIT_L(0); PG8_MMA(0, 1, At, B1); PG8_BAR;
            PG8_LDA(At, 0, 1); PG8_STAGE(PG8_SA(0, 0), a2, voffA);
            PG8_BAR; PG8_WAIT_L(0); PG8_MMA(1, 0, At, B0); PG8_BAR; PG8_SCHED;
            PG8_STAGE(PG8_SB(0, 1), b2 + hstep, voffB);
            PG8_WAIT_V(6); PG8_BAR; PG8_MMA(1, 1, At, B1); PG8_BAR;
            PG8_LDB(B0, 1, 0); PG8_SCHED; PG8_LDA(At, 1, 0); PG8_STAGE(PG8_SA(0, 1), a2 + hstep, voffA);
            PG8_WAIT_L(8); PG8_BAR; PG8_WAIT_L(0); PG8_MMA(0, 0, At, B0); PG8_BAR; PG8_SCHED;
            PG8_LDB(B1, 1, 1); PG8_STAGE(PG8_SB(1, 0), b3, voffB);
            PG8_BAR; PG8_WAIT_L(0); PG8_MMA(0, 1, At, B1); PG8_BAR;
            PG8_LDA(At, 1, 1); PG8_STAGE(PG8_SA(1, 0), a3, voffA);
            PG8_BAR; PG8_WAIT_L(0); PG8_MMA(1, 0, At, B0); PG8_BAR; PG8_SCHED;
            PG8_STAGE(PG8_SB(1, 1), b3 + hstep, voffB);
            PG8_WAIT_V(6); PG8_BAR; PG8_MMA(1, 1, At, B1); PG8_BAR;
            }
        }
        if constexpr (ALIGN_EPI) { if (wr == 0) PG8_BAR; }
        if constexpr (!Epi::AFTER_DRAIN) { E(acc, cur, wr, wc, fr, fq); S.done(cur); }
        if (!has_next) break;
#pragma unroll
        for (int a = 0; a < 2; ++a)
#pragma unroll
            for (int b = 0; b < 2; ++b)
#pragma unroll
                for (int m = 0; m < 4; ++m)
#pragma unroll
                    for (int n = 0; n < 2; ++n) acc[a][b][m][n] = (f32x4){0.f, 0.f, 0.f, 0.f};
        cur = nxt; cA = nA; cB = nB; ++ui;
        if constexpr (ALIGN_EPI) { if (wr == 1) PG8_BAR; }
    }
    PG8_WAIT_V(0);
    if constexpr (!ALIGN_EPI) { if (wr == 0) PG8_BAR; }
    PG8_BAR;
    if constexpr (Epi::AFTER_DRAIN) { E.fused(acc, cur, wr, wc, fr, fq, lds, wid, lane); S.done(cur); }
#undef PG8_SA
#undef PG8_SB
#undef PG8_STAGE
#undef PG8_LDA
#undef PG8_LDB
#undef PG8_MMA
#undef PG8_WAIT_V
#undef PG8_WAIT_L
#undef PG8_BAR
#undef PG8_SCHED
}
}
#ifndef PG8_SP2
#define PG8_SP2 true
#endif
#ifndef PG8_ALIGN
#define PG8_ALIGN true
#endif
constexpr int S_ = 8192, DM = 2048, DFF = 5632, NPROJ = 13056, NGU = 2 * DFF;
constexpr int IN_W = 12880;
constexpr int C_AQ = 0, C_AK = 1024, C_AV = 2048, C_IQ = 3072, C_BQ = 4096, C_BK = 5632, C_BV = 7168, C_GA = 8704, C_GB = 10752, C_IK = 12800, C_IW = 12864;
constexpr float ALPHA = 1.189207115002721f;
constexpr float LN_EPS = 1e-5f;
constexpr int TOPK = 256;

constexpr size_t MiB = 1u << 20;
constexpr size_t WS_CTL = 0, CTL_ZERO_BYTES = 256 * 1024;
constexpr size_t WS_WT_IN = 1 * MiB, WS_WT_A = 52 * MiB, WS_WT_B = 56 * MiB, WS_WT_OUT = 58 * MiB, WS_WT_GU = 66 * MiB, WS_WT_DOWN = 110 * MiB;
constexpr size_t WS_XB = 132 * MiB, WS_MERGED = 132 * MiB;
constexpr size_t WS_PROJ = 164 * MiB;
constexpr size_t WS_OA = 1 * MiB, WS_OB = 17 * MiB, WS_SELIDX = 25 * MiB, WS_SELCNT = 33 * MiB, WS_MASK = 34 * MiB, WS_SELIDX2 = 42 * MiB, WS_SELCNT2 = 50 * MiB;
constexpr size_t WS_H = 164 * MiB, WS_HB = 228 * MiB, WS_ACT = 260 * MiB;
constexpr size_t WS_END = 368 * MiB;
static_assert(WS_WT_IN + (size_t)NPROJ * DM * 2 <= WS_WT_A && WS_WT_GU + (size_t)NGU * DM * 2 <= WS_WT_DOWN && WS_WT_DOWN + (size_t)DM * DFF * 2 <= WS_XB, "ws map 1");
static_assert(WS_PROJ + (size_t)S_ * NPROJ * 2 <= WS_END && WS_ACT + (size_t)S_ * DFF * 2 <= WS_END && WS_MASK + 8 * MiB <= WS_WT_A, "ws map 2");

#define GAS __attribute__((address_space(1)))
#define LAS __attribute__((address_space(3)))
typedef unsigned short bf16;
typedef unsigned v4u __attribute__((ext_vector_type(4)));
typedef float f32x4 __attribute__((ext_vector_type(4)));
__device__ __forceinline__ unsigned f2bf(float f) { unsigned u = __builtin_bit_cast(unsigned, f); return (u + 0x7fffu + ((u >> 16) & 1u)) >> 16; }
__device__ __forceinline__ unsigned pk2(float lo, float hi) { return f2bf(lo) | (f2bf(hi) << 16); }
__device__ __forceinline__ float bf2f(bf16 v) { return __uint_as_float((unsigned)v << 16); }
__device__ __forceinline__ float wave_sum(float v) {
#pragma unroll
    for (int o = 1; o < 64; o <<= 1) v += __shfl_xor(v, o);
    return v;
}
__device__ __forceinline__ float wave_max(float v) {
#pragma unroll
    for (int o = 1; o < 64; o <<= 1) v = fmaxf(v, __shfl_xor(v, o));
    return v;
}

__device__ __forceinline__ void transpose_item(const float* W, int Nsrc, int K, bf16* WT, int n0, int k0, int srccol0, int nvalid, float* scr, int lane) {
#pragma unroll 8
    for (int i = 0; i < 32; ++i) { const int kk = 2 * i + (lane >> 5); const int c = lane & 31;
        scr[kk * 33 + c] = (c < nvalid) ? W[(size_t)(k0 + kk) * Nsrc + srccol0 + c] : 0.f; }
    __builtin_amdgcn_s_waitcnt(0xc07f); asm volatile("" ::: "memory");
    const int c = lane & 7;
#pragma unroll
    for (int j = 0; j < 4; ++j) { const int n = (lane >> 3) + 8 * j; const float* s = scr + (8 * c) * 33 + n;
        v4u o; o.x = pk2(s[0 * 33], s[1 * 33]); o.y = pk2(s[2 * 33], s[3 * 33]); o.z = pk2(s[4 * 33], s[5 * 33]); o.w = pk2(s[6 * 33], s[7 * 33]);
        *(v4u*)(WT + (size_t)(n0 + n) * K + k0 + 8 * c) = o; }
    __builtin_amdgcn_s_waitcnt(0xc07f); asm volatile("" ::: "memory");
}
struct ProArgs { const float *x, *w_in, *w_a, *w_b, *w_out, *w_gate, *w_up, *w_down; unsigned char* ws; };
__device__ __forceinline__ void prologue_body(const ProArgs& a, float* scr  , int gw, int NGW, int lane) {
    bf16* wt_in = (bf16*)(a.ws + WS_WT_IN); bf16* wt_a = (bf16*)(a.ws + WS_WT_A); bf16* wt_b = (bf16*)(a.ws + WS_WT_B); bf16* wt_out = (bf16*)(a.ws + WS_WT_OUT);
    bf16* wt_gu = (bf16*)(a.ws + WS_WT_GU); bf16* wt_down = (bf16*)(a.ws + WS_WT_DOWN); bf16* xb = (bf16*)(a.ws + WS_XB);
    constexpr int I_IN = (DM / 64) * (NPROJ / 32), I_A = (1024 / 64) * (DM / 32), I_B = (512 / 64) * (DM / 32), I_OUT = (DM / 64) * (DM / 32), I_GU = (DM / 64) * (NGU / 32), I_DN = (DFF / 64) * (DM / 32);
    constexpr int NITEMS = I_IN + I_A + I_B + I_OUT + I_GU + I_DN;
    for (int it = gw; it < NITEMS; it += NGW) {
        int r = it;
        if (r < I_IN) { const int nb = r % (NPROJ / 32), kb = r / (NPROJ / 32), n0 = nb * 32;
            int src, nv = 32;
            if (n0 < 4096) src = n0; else if (n0 < 12800) src = n0 + 80; else if (n0 < 12880) { src = n0 - 12800 + 4096; nv = (12880 - n0) < 32 ? (12880 - n0) : 32; } else { src = 0; nv = 0; }
            transpose_item(a.w_in, IN_W, DM, wt_in, n0, kb * 64, src, nv, scr, lane); continue; }
        r -= I_IN;
        if (r < I_A) { const int nb = r % (DM / 32), kb = r / (DM / 32); transpose_item(a.w_a, DM, 1024, wt_a, nb * 32, kb * 64, nb * 32, 32, scr, lane); continue; }
        r -= I_A;
        if (r < I_B) { const int nb = r % (DM / 32), kb = r / (DM / 32); transpose_item(a.w_b, DM, 512, wt_b, nb * 32, kb * 64, nb * 32, 32, scr, lane); continue; }
        r -= I_B;
        if (r < I_OUT) { const int nb = r % (DM / 32), kb = r / (DM / 32); transpose_item(a.w_out, DM, DM, wt_out, nb * 32, kb * 64, nb * 32, 32, scr, lane); continue; }
        r -= I_OUT;
        if (r < I_GU) { const int nb = r % (NGU / 32), kb = r / (NGU / 32), n0 = nb * 32; const int half = (n0 >> 7) & 1, j = n0 >> 8, i = n0 & 127;
            transpose_item(half ? a.w_up : a.w_gate, DFF, DM, wt_gu, n0, kb * 64, 128 * j + i, 32, scr, lane); continue; }
        r -= I_GU;
        { const int nb = r % (DM / 32), kb = r / (DM / 32); transpose_item(a.w_down, DM, DFF, wt_down, nb * 32, kb * 64, nb * 32, 32, scr, lane); }
    }
    for (int m = gw; m < S_; m += NGW) {
        const f32x4* xr = (const f32x4*)(a.x + (size_t)m * DM) + lane; unsigned long long* o8 = (unsigned long long*)(xb + (size_t)m * DM) + lane;
#pragma unroll
        for (int j = 0; j < 8; ++j) { const f32x4 v = xr[64 * j]; o8[64 * j] = (unsigned long long)pk2(v.x, v.y) | ((unsigned long long)pk2(v.z, v.w) << 32); }
    }
}
__device__ __forceinline__ void ln_row(const float* Y, const float* g, const float* b, float* outf, bf16* outb, int row, int lane) {
    const f32x4* yr = (const f32x4*)(Y + (size_t)row * DM) + lane;
    f32x4 v[8]; float s = 0.f;
#pragma unroll
    for (int j = 0; j < 8; ++j) { v[j] = yr[64 * j]; s += (v[j].x + v[j].y) + (v[j].z + v[j].w); }
    const float mean = wave_sum(s) * (1.f / DM); float s2 = 0.f;
#pragma unroll
    for (int j = 0; j < 8; ++j) { v[j] = v[j] - mean; s2 += (v[j].x * v[j].x + v[j].y * v[j].y) + (v[j].z * v[j].z + v[j].w * v[j].w); }
    const float rstd = 1.f / sqrtf(wave_sum(s2) * (1.f / DM) + LN_EPS);
#pragma unroll
    for (int j = 0; j < 8; ++j) { const f32x4 gg = ((const f32x4*)g)[lane + 64 * j], bb = ((const f32x4*)b)[lane + 64 * j]; const f32x4 o = v[j] * rstd * gg + bb;
        ((f32x4*)(outf + (size_t)row * DM))[lane + 64 * j] = o;
        if (outb) ((unsigned long long*)(outb + (size_t)row * DM))[lane + 64 * j] = (unsigned long long)pk2(o.x, o.y) | ((unsigned long long)pk2(o.z, o.w) << 32); }
}

__device__ __forceinline__ unsigned ord_key(float f) { unsigned u = __float_as_uint(f); return (u & 0x80000000u) ? ~u : (u | 0x80000000u); }
template <int NT> __device__ __forceinline__ unsigned block_exscan(unsigned v, unsigned* sh, unsigned* tot) {
    const int lane = threadIdx.x & 63, w = threadIdx.x >> 6;
    unsigned inc = v;
#pragma unroll
    for (int o = 1; o < 64; o <<= 1) { unsigned t = __shfl_up(inc, o); if (lane >= o) inc += t; }
    __syncthreads();
    if (lane == 63) sh[w] = inc;
    __syncthreads();
    unsigned base = 0, total = 0;
#pragma unroll
    for (int i = 0; i < NT / 64; ++i) { const unsigned s = sh[i]; if (i < w) base += s; total += s; }
    *tot = total;
    return base + inc - v;
}
constexpr int NTK_LDS_BYTES = (8192 + 1024 + 16 + 256 + 8 + 8) * 4;
template <int NT> __device__ __forceinline__ void naive_topk_query(int t, const bf16* proj, int* sel_idx, int* sel_cnt, float* ldsf) {
    float* sc = ldsf; float* qs = sc + 8192; float* wsh = qs + 1024; unsigned* hist = (unsigned*)(wsh + 16); unsigned* shs = hist + 256; unsigned* shp = shs + 8;
    const int tid = threadIdx.x; const int n = t + 1;
    const bf16* prow = proj + (size_t)t * NPROJ;
    __syncthreads();
    for (int i = tid; i < 1024; i += NT) qs[i] = bf2f(prow[C_IQ + i]);
    if (tid < 16) wsh[tid] = bf2f(prow[C_IW + tid]) * 0.25f;
    __syncthreads();
    for (int s = tid; s < n; s += NT) {
        const bf16* kr = proj + (size_t)s * NPROJ + C_IK; float kf[64];
#pragma unroll
        for (int i = 0; i < 8; ++i) { const v4u w = ((const v4u*)kr)[i];
            kf[8 * i + 0] = __uint_as_float(w.x << 16); kf[8 * i + 1] = __uint_as_float(w.x & 0xffff0000u); kf[8 * i + 2] = __uint_as_float(w.y << 16); kf[8 * i + 3] = __uint_as_float(w.y & 0xffff0000u);
            kf[8 * i + 4] = __uint_as_float(w.z << 16); kf[8 * i + 5] = __uint_as_float(w.z & 0xffff0000u); kf[8 * i + 6] = __uint_as_float(w.w << 16); kf[8 * i + 7] = __uint_as_float(w.w & 0xffff0000u); }
        float score = 0.f;
        for (int h = 0; h < 16; ++h) { float d = 0.f;
#pragma unroll
            for (int i = 0; i < 64; ++i) d = fmaf(qs[h * 64 + i], kf[i], d);
            score = fmaf(wsh[h], fmaxf(d * 0.125f, 0.f), score); }
        sc[s] = score;
    }
    __syncthreads();
    int* out = sel_idx + (size_t)t * TOPK;
    if (n <= TOPK) { if (tid < TOPK) out[tid] = tid < n ? tid : -1; if (tid == 0) sel_cnt[t] = n; return; }
    if (tid == 0) { shp[0] = 0u; shp[1] = TOPK; }
    unsigned maskbits = 0u;
    for (int round = 0; round < 4; ++round) {
        const int shift = 24 - 8 * round;
        if (tid < 256) hist[tid] = 0u;
        __syncthreads();
        const unsigned prefix = shp[0];
        for (int s = tid; s < n; s += NT) { const unsigned k = ord_key(sc[s]); if ((k & maskbits) == prefix) atomicAdd(&hist[(k >> shift) & 255u], 1u); }
        __syncthreads();
        if (tid == 0) { unsigned r = shp[1], cum = 0; int b = 255; for (; b > 0; --b) { if (cum + hist[b] >= r) break; cum += hist[b]; } shp[1] = r - cum; shp[0] = prefix | ((unsigned)b << shift); }
        maskbits |= 255u << shift;
        __syncthreads();
    }
    const unsigned tau = shp[0]; const unsigned rt = shp[1];
    constexpr int CH = S_ / NT;
    const int s0 = tid * CH;
    unsigned nt = 0;
    for (int i = 0; i < CH; ++i) { const int s = s0 + i; if (s < n && ord_key(sc[s]) == tau) ++nt; }
    unsigned tot; unsigned tr = block_exscan<NT>(nt, shs, &tot);
    unsigned ns = 0; unsigned flags = 0;
    for (int i = 0; i < CH; ++i) { const int s = s0 + i; if (s < n) { const unsigned k = ord_key(sc[s]); bool sel = k > tau; if (k == tau) { sel = tr < rt; ++tr; } if (sel) { flags |= 1u << i; ++ns; } } }
    unsigned sbase = block_exscan<NT>(ns, shs, &tot);
    for (int i = 0; i < CH; ++i) if (flags & (1u << i)) out[sbase++] = s0 + i;
    if (tid == 0) sel_cnt[t] = (int)tot;
}
constexpr int NAA_LDS_WAVE = (128 + 256 + 256) * 4;
__device__ __forceinline__ void naive_attn_a_wave(int t, int h, const bf16* proj, const int* sel_idx, const int* sel_cnt, bf16* oa, float* ldsw, int lane) {
    float* q = ldsw; float* pw = q + 128; int* sel = (int*)(pw + 256);
    const bf16* prow = proj + (size_t)t * NPROJ;
    for (int i = lane; i < 128; i += 64) q[i] = bf2f(prow[C_AQ + h * 128 + i]);
    for (int i = lane; i < 256; i += 64) sel[i] = sel_idx[(size_t)t * TOPK + i];
    const int cnt = sel_cnt[t];
    __builtin_amdgcn_s_waitcnt(0xc07f); asm volatile("" ::: "memory");
    const float slope = exp2f(-0.4f * (float)(13 + h));
    float lg[4]; float mx = -INFINITY;
#pragma unroll
    for (int i = 0; i < 4; ++i) { const int k = lane + 64 * i; lg[i] = -INFINITY;
        if (k < cnt) { const int s = sel[k]; const v4u* kr = (const v4u*)(proj + (size_t)s * NPROJ + C_AK + h * 128); float d = 0.f;
            for (int c = 0; c < 16; ++c) { const v4u wv = kr[c];
                d = fmaf(q[8 * c + 0], __uint_as_float(wv.x << 16), d); d = fmaf(q[8 * c + 1], __uint_as_float(wv.x & 0xffff0000u), d);
                d = fmaf(q[8 * c + 2], __uint_as_float(wv.y << 16), d); d = fmaf(q[8 * c + 3], __uint_as_float(wv.y & 0xffff0000u), d);
                d = fmaf(q[8 * c + 4], __uint_as_float(wv.z << 16), d); d = fmaf(q[8 * c + 5], __uint_as_float(wv.z & 0xffff0000u), d);
                d = fmaf(q[8 * c + 6], __uint_as_float(wv.w << 16), d); d = fmaf(q[8 * c + 7], __uint_as_float(wv.w & 0xffff0000u), d); }
            lg[i] = d * 0.08838834764831845f - slope * (float)(t - s); }
        mx = fmaxf(mx, lg[i]); }
    mx = wave_max(mx); float sum = 0.f;
#pragma unroll
    for (int i = 0; i < 4; ++i) { lg[i] = (lane + 64 * i < cnt) ? __expf(lg[i] - mx) : 0.f; sum += lg[i]; }
    sum = wave_sum(sum); const float inv = 1.f / sum;
#pragma unroll
    for (int i = 0; i < 4; ++i) pw[lane + 64 * i] = lg[i] * inv;
    __builtin_amdgcn_s_waitcnt(0xc07f); asm volatile("" ::: "memory");
    float o0 = 0.f, o1 = 0.f;
    for (int k = 0; k < cnt; ++k) { const int s = sel[k]; const unsigned vv = *(const unsigned*)(proj + (size_t)s * NPROJ + C_AV + h * 128 + 2 * lane); const float p = pw[k];
        o0 = fmaf(p, __uint_as_float(vv << 16), o0); o1 = fmaf(p, __uint_as_float(vv & 0xffff0000u), o1); }
    *(unsigned*)(oa + (size_t)t * 1024 + h * 128 + 2 * lane) = pk2(o0, o1);
    __builtin_amdgcn_s_waitcnt(0xc07f); asm volatile("" ::: "memory");
}
constexpr int NAB_LDS_WAVE = (384 + 388) * 4;
__device__ __forceinline__ void naive_attn_b_wave(int t, int j, const bf16* proj, bf16* ob, float* ldsw, int lane) {
    float* qsh = ldsw; float* pw = qsh + 384;
    const bf16* prow = proj + (size_t)t * NPROJ;
    for (int g = 0; g < 3; ++g) for (int i = lane; i < 128; i += 64) qsh[g * 128 + i] = bf2f(prow[C_BQ + (4 * g + j) * 128 + i]);
    __builtin_amdgcn_s_waitcnt(0xc07f); asm volatile("" ::: "memory");
    float mx = -INFINITY;
    for (int g = 0; g < 3; ++g) { const int d = g == 0 ? 1 : (g == 1 ? 4 : 16); const int m = t / d; const int nk = (m < 128 ? m : 128) + 1; const int head = 4 * g + j;
        const float slope = exp2f(-0.4f * (float)(head + 1)); const float* q = qsh + g * 128;
        for (int i = lane; i < 129; i += 64) { float l = -INFINITY;
            if (i < nk) { const int s = t - i * d; const v4u* kr = (const v4u*)(proj + (size_t)s * NPROJ + C_BK + head * 128); float dd = 0.f;
                for (int c = 0; c < 16; ++c) { const v4u wv = kr[c];
                    dd = fmaf(q[8 * c + 0], __uint_as_float(wv.x << 16), dd); dd = fmaf(q[8 * c + 1], __uint_as_float(wv.x & 0xffff0000u), dd);
                    dd = fmaf(q[8 * c + 2], __uint_as_float(wv.y << 16), dd); dd = fmaf(q[8 * c + 3], __uint_as_float(wv.y & 0xffff0000u), dd);
                    dd = fmaf(q[8 * c + 4], __uint_as_float(wv.z << 16), dd); dd = fmaf(q[8 * c + 5], __uint_as_float(wv.z & 0xffff0000u), dd);
                    dd = fmaf(q[8 * c + 6], __uint_as_float(wv.w << 16), dd); dd = fmaf(q[8 * c + 7], __uint_as_float(wv.w & 0xffff0000u), dd); }
                l = dd * 0.08838834764831845f - slope * (float)(i * d); }
            pw[g * 129 + i] = l; mx = fmaxf(mx, l); } }
    mx = wave_max(mx);
    __builtin_amdgcn_s_waitcnt(0xc07f); asm volatile("" ::: "memory");
    float sum = 0.f;
    for (int i = lane; i < 387; i += 64) { const float p = __expf(pw[i] - mx); pw[i] = p; sum += p; }
    sum = wave_sum(sum); const float inv = 1.f / sum;
    __builtin_amdgcn_s_waitcnt(0xc07f); asm volatile("" ::: "memory");
    float o0 = 0.f, o1 = 0.f;
    for (int g = 0; g < 3; ++g) { const int d = g == 0 ? 1 : (g == 1 ? 4 : 16); const int m = t / d; const int nk = (m < 128 ? m : 128) + 1; const int head = 4 * g + j;
        for (int i = 0; i < nk; ++i) { const int s = t - i * d; const unsigned vv = *(const unsigned*)(proj + (size_t)s * NPROJ + C_BV + head * 128 + 2 * lane); const float p = pw[g * 129 + i];
            o0 = fmaf(p, __uint_as_float(vv << 16), o0); o1 = fmaf(p, __uint_as_float(vv & 0xffff0000u), o1); } }
    *(unsigned*)(ob + (size_t)t * 512 + j * 128 + 2 * lane) = pk2(o0 * inv, o1 * inv);
    __builtin_amdgcn_s_waitcnt(0xc07f); asm volatile("" ::: "memory");
}

constexpr int NWAVES = 8;
constexpr int RING_BYTES = 131072;
constexpr int LDSCTL_OFF = RING_BYTES, MISC_OFF = LDSCTL_OFF + 320;
constexpr int LDS_BYTES = 147456;
constexpr int CW_TMO = 0, CW_BAR = 4096;
typedef GAS unsigned gu32;
#define RLX_AGENT __ATOMIC_RELAXED, __HIP_MEMORY_SCOPE_AGENT
namespace tk {
typedef short bf16x8 __attribute__((ext_vector_type(8)));
typedef float f32x16 __attribute__((ext_vector_type(16)));
constexpr int KT = 128, KT_BYTES = KT * 128, HIST_OFF = 2 * KT_BYTES, HIST_Q_BYTES = 4096, LDS_NEED = HIST_OFF + 16 * HIST_Q_BYTES;
constexpr int FLAG_OFF = 131072 + 320 + 64;
__device__ __forceinline__ int crow(int r, int hi) { return (r & 3) + 8 * (r >> 2) + 4 * hi; }
__device__ __forceinline__ unsigned okey(float f) { const unsigned u = __float_as_uint(f); return (u & 0x80000000u) ? ~u : (u | 0x80000000u); }
__device__ __forceinline__ float vmax0(float a) { return __builtin_amdgcn_fmed3f(a, 0.f, __builtin_inff()); }

struct Lane {
    bf16x8 af[4]; float wv[16]; unsigned koff[4]; int kperm; unsigned lower; int tq;
};
template <int MODE> __device__ __forceinline__ void pass(const Lane& L, const bf16* proj, unsigned* maskout, LAS unsigned char* lds, int nt, int tid, int lane, int wave,
                                                          unsigned prefix, unsigned mbits, int shift, unsigned bmask, bool act, unsigned tau, unsigned req, int t0) {
    const int hi = lane >> 5;
    LAS unsigned* hist = (LAS unsigned*)(lds + HIST_OFF + (wave * 2 + hi) * HIST_Q_BYTES);
    const int r0 = tid >> 3, c0 = tid & 7;
    const unsigned w0 = (unsigned)(r0 * 128 + 16 * (c0 ^ ((r0 >> 1) & 7))), w1 = (unsigned)((r0 + 64) * 128 + 16 * (c0 ^ (((r0 + 64) >> 1) & 7)));
    const bf16* g0 = proj + (size_t)r0 * NPROJ + C_IK + c0 * 8;
    v4u s0 = *(const v4u*)g0, s1 = *(const v4u*)(g0 + (size_t)64 * NPROJ);
    *(LAS v4u*)(lds + w0) = s0; *(LAS v4u*)(lds + w1) = s1;
    __syncthreads();
    unsigned run = 0;
    unsigned wq0h0 = 0, wq0h1 = 0, wq1h0 = 0, wq1h1 = 0;
    for (int i = 0; i < nt; ++i) {
        const bool more = (i + 1 < nt);
        if (more) { const bf16* g = g0 + (size_t)(i + 1) * KT * NPROJ; s0 = *(const v4u*)g; s1 = *(const v4u*)(g + (size_t)64 * NPROJ); }
        LAS unsigned char* buf = lds + (i & 1) * KT_BYTES;
#pragma unroll
        for (int j = 0; j < 4; ++j) {
            f32x16 c = {0.f, 0.f, 0.f, 0.f, 0.f, 0.f, 0.f, 0.f, 0.f, 0.f, 0.f, 0.f, 0.f, 0.f, 0.f, 0.f};
#pragma unroll
            for (int ks = 0; ks < 4; ++ks) { const bf16x8 kb = *(const LAS bf16x8*)(buf + L.koff[ks] + 4096 * j); c = __builtin_amdgcn_mfma_f32_32x32x16_bf16(L.af[ks], kb, c, 0, 0, 0); }
            float score = 0.f;
#pragma unroll
            for (int r = 0; r < 16; ++r) score = __builtin_fmaf(L.wv[r], vmax0(c[r]), score);
            const unsigned key = okey(score);
            const int s = i * KT + 32 * j + L.kperm;
            const bool valid = s <= L.tq;
            if (MODE == 0) {
                if (act && valid && ((key & mbits) == prefix)) { const unsigned bin = (key >> shift) & bmask; __hip_atomic_fetch_add(hist + (bin >> 1), 1u << (16 * (bin & 1)), __ATOMIC_RELAXED, __HIP_MEMORY_SCOPE_WORKGROUP); }
            } else {
                const bool tie = valid && key == tau;
                const unsigned long long tb = __ballot(tie);
                bool sel = valid && key > tau;
                if (tb) { const unsigned tb32 = hi ? (unsigned)(tb >> 32) : (unsigned)tb; const unsigned rank = run + __popc(tb32 & L.lower); if (tie && rank < req) sel = true; run += __popc(tb32); }
                const unsigned long long sb = __ballot(sel);
                const unsigned q0 = (unsigned)sb, q1 = (unsigned)(sb >> 32);
                if ((j & 1) == 0) { wq0h0 = q0 & 0xffffu; wq0h1 = q0 >> 16; wq1h0 = q1 & 0xffffu; wq1h1 = q1 >> 16; }
                else { wq0h0 |= q0 << 16; wq0h1 |= q0 & 0xffff0000u; wq1h0 |= q1 << 16; wq1h1 |= q1 & 0xffff0000u;
                    if (lane < 4) { const unsigned v = lane == 0 ? wq0h0 : (lane == 1 ? wq0h1 : (lane == 2 ? wq1h0 : wq1h1));
                        maskout[((size_t)(t0 + (lane >> 1)) * 128 + (i * 2 + (j >> 1))) * 2 + (lane & 1)] = v; } }
            }
        }
        if (more) { LAS unsigned char* nb = lds + ((i + 1) & 1) * KT_BYTES; *(LAS v4u*)(nb + w0) = s0; *(LAS v4u*)(nb + w1) = s1; }
        __syncthreads();
    }
}
__device__ __forceinline__ void topk_block(int b, const bf16* proj, unsigned* maskout, LAS unsigned char* lds, int tid, int lane, int wave) {
    const int lam = lane & 31, hi = lane >> 5;
    Lane L;
    L.kperm = crow(lam & 15, lam >> 4);
    const int t0 = 16 * b + 2 * wave; L.tq = t0 + hi;
    { const int qsel = (lam >> 2) & 1, head = (lam & 3) + 4 * (lam >> 3);
      const bf16* qp = proj + (size_t)(t0 + qsel) * NPROJ + C_IQ + head * 64 + 8 * hi;
#pragma unroll
      for (int ks = 0; ks < 4; ++ks) L.af[ks] = *(const bf16x8*)(qp + 16 * ks); }
    { const v4u a = *(const v4u*)(proj + (size_t)L.tq * NPROJ + C_IW), bq = *(const v4u*)(proj + (size_t)L.tq * NPROJ + C_IW + 8);
      const unsigned wd[8] = {a.x, a.y, a.z, a.w, bq.x, bq.y, bq.z, bq.w};
#pragma unroll
      for (int r = 0; r < 8; ++r) { L.wv[2 * r] = __uint_as_float(wd[r] << 16) * 0.03125f; L.wv[2 * r + 1] = __uint_as_float(wd[r] & 0xffff0000u) * 0.03125f; } }
    { const int sw = (L.kperm >> 1) & 7;
#pragma unroll
      for (int ks = 0; ks < 4; ++ks) L.koff[ks] = (unsigned)(L.kperm * 128 + 16 * ((2 * ks + hi) ^ sw)); }
    { unsigned lw = 0; for (int l2 = 0; l2 < 32; ++l2) if (crow(l2 & 15, l2 >> 4) < L.kperm) lw |= 1u << l2; L.lower = lw; }
    const int tmax = 16 * b + 15; const int nt = tmax / KT + 1; const int ntm = ((b >> 4) + 1) * 2;
    unsigned tau = 0u, req = 0xffffffffu;
    if (tmax >= TOPK) {
        LAS unsigned* hist = (LAS unsigned*)(lds + HIST_OFF + (wave * 2 + hi) * HIST_Q_BYTES);
        unsigned prefix = 0u, mbits = 0u, r = TOPK; bool done = false;
        for (int round = 0; round < 3; ++round) {
            const int shift = round == 0 ? 21 : (round == 1 ? 10 : 0); const unsigned bmask = round == 2 ? 1023u : 2047u;
            { LAS v4u* hz = (LAS v4u*)(lds + HIST_OFF + wave * 2 * HIST_Q_BYTES);
#pragma unroll
              for (int k = 0; k < 8; ++k) hz[lane + 64 * k] = (v4u){0u, 0u, 0u, 0u}; }
            pass<0>(L, proj, maskout, lds, nt, tid, lane, wave, prefix, mbits, shift, bmask, !done, 0u, 0u, t0);
            unsigned cw[32]; unsigned sum = 0;
#pragma unroll
            for (int k = 0; k < 8; ++k) { const v4u v = *(const LAS v4u*)((LAS unsigned char*)hist + lam * 128 + 16 * k); cw[4 * k] = v.x; cw[4 * k + 1] = v.y; cw[4 * k + 2] = v.z; cw[4 * k + 3] = v.w; }
#pragma unroll
            for (int k = 0; k < 32; ++k) sum += (cw[k] & 0xffffu) + (cw[k] >> 16);
            unsigned suf = sum;
#pragma unroll
            for (int o = 1; o < 32; o <<= 1) { const unsigned tt = __shfl_down(suf, o, 32); if (lam + o < 32) suf += tt; }
            unsigned cum = suf - sum;
            const bool mine = !done && cum < r && r <= suf;
            unsigned fb = 0, fr = 0, fc = 0;
            if (mine) {
#pragma unroll
                for (int k = 31; k >= 0; --k) {
                    const unsigned chi = cw[k] >> 16, clo = cw[k] & 0xffffu;
                    if (fc == 0 && cum + chi >= r) { fb = 64 * lam + 2 * k + 1; fr = r - cum; fc = chi; } if (fc == 0) cum += chi;
                    if (fc == 0 && cum + clo >= r) { fb = 64 * lam + 2 * k; fr = r - cum; fc = clo; } if (fc == 0) cum += clo;
                }
            }
            const unsigned long long mb = __ballot(mine);
            const unsigned mb32 = hi ? (unsigned)(mb >> 32) : (unsigned)mb;
            if (mb32) { const int src = (hi << 5) + (__ffs(mb32) - 1);
                fb = __shfl(fb, src); fr = __shfl(fr, src); fc = __shfl(fc, src);
                prefix |= fb << shift; r = fr; if (fc == fr) done = true; }
            mbits |= bmask << shift;
            { volatile LAS unsigned* flag = (volatile LAS unsigned*)(lds + FLAG_OFF);
              if (__ballot(!done) != 0ull && lane == 0) *flag = 1u;
              __syncthreads();
              const unsigned any = *flag;
              __syncthreads();
              if (tid == 0) *flag = 0u;
              if (!any) break; }
        }
        tau = prefix; req = done ? 0xffffffffu : r;
    }
    pass<1>(L, proj, maskout, lds, ntm, tid, lane, wave, 0u, 0u, 0, 0u, false, tau, req, t0);
}
}
__device__ __forceinline__ void mask_to_list_wave(int t, const unsigned* mask, int* sel_idx, int* sel_cnt, int lane, unsigned* dbg_over = nullptr) {
    unsigned long long nat[2]; unsigned cnt[2];
#pragma unroll
    for (int i = 0; i < 2; ++i) { const int T = lane + 64 * i; unsigned long long m = 0ull;
        if (64 * T <= t) { const unsigned w0 = mask[((size_t)t * 128 + T) * 2], w1 = mask[((size_t)t * 128 + T) * 2 + 1];
            for (int bit = 0; bit < 32; ++bit) { const int j = bit >> 4, r = bit & 15;
                if ((w0 >> bit) & 1u) m |= 1ull << (32 * j + tk::crow(r, 0));
                if ((w1 >> bit) & 1u) m |= 1ull << (32 * j + tk::crow(r, 1)); } }
        nat[i] = m; cnt[i] = (unsigned)__popcll(m); }
    unsigned inc0 = cnt[0], inc1 = cnt[1];
#pragma unroll
    for (int o = 1; o < 64; o <<= 1) { const unsigned a = __shfl_up(inc0, o), b = __shfl_up(inc1, o); if (lane >= o) { inc0 += a; inc1 += b; } }
    const unsigned tot0 = __shfl(inc0, 63), tot1 = __shfl(inc1, 63);
    unsigned pos0 = inc0 - cnt[0], pos1 = tot0 + inc1 - cnt[1];
    for (int k = 0; k < 64; ++k) { if ((nat[0] >> k) & 1ull) { if (pos0 < TOPK) sel_idx[(size_t)t * TOPK + pos0] = 64 * lane + k; ++pos0; } }
    for (int k = 0; k < 64; ++k) { if ((nat[1] >> k) & 1ull) { if (pos1 < TOPK) sel_idx[(size_t)t * TOPK + pos1] = 64 * (lane + 64) + k; ++pos1; } }
    if (lane == 0) sel_cnt[t] = (int)((tot0 + tot1) < (unsigned)TOPK ? (tot0 + tot1) : (unsigned)TOPK);
    if (lane == 0 && dbg_over && tot0 + tot1 > (unsigned)TOPK) atomicAdd(dbg_over, 1u);
}
__device__ __forceinline__ void list_compare_wave(int t, const int* ia, const int* ca, const int* ib, const int* cb, unsigned* counter, int lane) {
    const int na = ca[t], nb = cb[t]; bool bad = na != nb;
    for (int i = lane; i < TOPK; i += 64) if (i < na && i < nb && ia[(size_t)t * TOPK + i] != ib[(size_t)t * TOPK + i]) bad = true;
    if (__ballot(bad) && lane == 0) atomicAdd(counter, 1u);
}
#define XB_TMO      128
#define XB_XCNT(j)  (256  + 64 * (j))
#define XB_XSUB(j)  (1280 + 64 * (j))
#define XB_XGEN(j)  (2304 + 64 * (j))
#define XB_TOP      3328
#define XB_TOPGEN   3392
#define XCD_BAR_WORDS 3456
#define XB_SPIN_CAP (1u << 22)

__device__ __forceinline__ unsigned xb_ld(unsigned* p)              { return __hip_atomic_load(p, __ATOMIC_RELAXED, __HIP_MEMORY_SCOPE_AGENT); }
__device__ __forceinline__ unsigned xb_add(unsigned* p, unsigned v) { return __hip_atomic_fetch_add(p, v, __ATOMIC_RELAXED, __HIP_MEMORY_SCOPE_AGENT); }
__device__ __forceinline__ unsigned xb_xcc_id() { return (unsigned)__builtin_amdgcn_s_getreg((3 << 11) | 20) & 0xFu; }
#define XB_SPIN(cond, bar) do { unsigned _sp = 0; while (cond) { __builtin_amdgcn_s_sleep(1); \
    if ((++_sp & 255u) == 0u) { if (xb_ld(&(bar)[XB_TMO])) break; if (_sp > XB_SPIN_CAP) { atomicAdd(&(bar)[XB_TMO], 1u); break; } } } } while (0)

struct XcdBarrier {
    unsigned* bar; unsigned x;
    volatile LAS unsigned* st;
};

__device__ __forceinline__ XcdBarrier xcd_barrier_post(unsigned* bar, volatile LAS unsigned* st) {
    XcdBarrier b; b.bar = bar; b.x = xb_xcc_id(); b.st = st;
    if (threadIdx.x == 0) (void)xb_add(&bar[XB_XCNT(b.x)], 1u);
    return b;
}
__device__ __forceinline__ void xcd_barrier_complete(unsigned* bar, unsigned x, unsigned& nloc, unsigned& nx) {
    const unsigned G = gridDim.x * gridDim.y * gridDim.z;
    unsigned sum, cnt, mine, sp = 0u;
    for (;;) {
        sum = 0u; cnt = 0u; mine = 0u;
#pragma unroll
        for (unsigned j = 0; j < 16; ++j) { const unsigned c = xb_ld(&bar[XB_XCNT(j)]); sum += c; cnt += (c > 0u) ? 1u : 0u; mine = (j == x) ? c : mine; }
        if (sum == G) break;
        __builtin_amdgcn_s_sleep(1);
        if ((++sp & 255u) == 0u) { if (xb_ld(&bar[XB_TMO])) break; if (sp > XB_SPIN_CAP) { atomicAdd(&bar[XB_TMO], 1u); break; } }
    }
    nloc = mine > 0u ? mine : 1u; nx = cnt > 0u ? cnt : 1u;
}

__device__ __forceinline__ void xcd_barrier(const XcdBarrier& b) {
    asm volatile("s_waitcnt vmcnt(0)" ::: "memory");
    __syncthreads();
    if (threadIdx.x == 0) {
        unsigned* bar = b.bar;
        __builtin_amdgcn_s_waitcnt(0);
        unsigned nloc = b.st[0], nx = b.st[1];
        if (nloc == 0u) { xcd_barrier_complete(bar, b.x, nloc, nx); b.st[0] = nloc; b.st[1] = nx; }
        const unsigned old = xb_add(&bar[XB_XSUB(b.x)], 1u);
        const unsigned gen = old / nloc;
        if (old + 1u == (gen + 1u) * nloc) {
            __builtin_amdgcn_fence(__ATOMIC_RELEASE, "agent");
            asm volatile("s_waitcnt vmcnt(0)" ::: "memory");
            const unsigned og = xb_add(&bar[XB_TOP], 1u);
            const unsigned tg = og / nx;
            if (og + 1u == (tg + 1u) * nx) xb_add(&bar[XB_TOPGEN], 1u);
            else XB_SPIN(xb_ld(&bar[XB_TOPGEN]) == tg, bar);
            __builtin_amdgcn_fence(__ATOMIC_ACQUIRE, "agent");
            xb_add(&bar[XB_XGEN(b.x)], 1u);
            asm volatile("s_waitcnt vmcnt(0)" ::: "memory");
        } else {
            XB_SPIN(xb_ld(&bar[XB_XGEN(b.x)]) == gen, bar);
            __builtin_amdgcn_fence(__ATOMIC_ACQUIRE, "agent");
            asm volatile("s_waitcnt vmcnt(0)" ::: "memory");
        }
    }
    __syncthreads();
}

enum { P_PRO = 0, P_PROJ, P_TOPK, P_ATTN, P_MERGE, P_WOUT, P_LN1, P_GU, P_DOWN, P_LN2, NPH };
struct Args { const float* in[12]; float* out; unsigned char* ws; int ph_lo, ph_hi, li, pad; };
__global__ void __launch_bounds__(NWAVES * 64, 2) mega_kernel(Args args) {
    extern __shared__ __attribute__((aligned(16))) unsigned char lds_raw[];
    LAS unsigned char* lds = (LAS unsigned char*)lds_raw;
    volatile LAS unsigned* MISC = (volatile LAS unsigned*)(lds + MISC_OFF);
    const int tid = threadIdx.x, lane = tid & 63, wave = __builtin_amdgcn_readfirstlane(tid >> 6);
    const int G = gridDim.x, bx = blockIdx.x; const int vcu = (G % 8 == 0) ? (bx % 8) * (G / 8) + bx / 8 : bx;
    unsigned char* ws = args.ws; unsigned* ctl = (unsigned*)(ws + WS_CTL);
    for (int u = tid; u < (LDS_BYTES - LDSCTL_OFF) / 4; u += NWAVES * 64) ((LAS unsigned*)(lds + LDSCTL_OFF))[u] = 0u;
    __syncthreads();
    XcdBarrier bar = xcd_barrier_post(ctl + CW_BAR + args.li * XCD_BAR_WORDS, MISC + 8);
    const int lo = args.ph_lo, hi = args.ph_hi;
#define IN(k) (lo <= (k) && (k) < hi)
#define SEAM(k) do { if (IN(k) && IN((k) + 1)) xcd_barrier(bar); } while (0)
    using pg8::bf16_t;
    const float* x = args.in[0]; float* out = args.out;
    const bf16* proj = (const bf16*)(ws + WS_PROJ);

    if (IN(P_PRO)) {
        ProArgs pa{x, args.in[1], args.in[2], args.in[3], args.in[4], args.in[7], args.in[8], args.in[9], ws};
        prologue_body(pa, (float*)(lds_raw + wave * 16384), vcu * NWAVES + wave, G * NWAVES, lane);
    }
    SEAM(P_PRO);
    if (IN(P_PROJ)) {
        pg8::Gemm g{(const bf16_t*)(ws + WS_XB), (const bf16_t*)(ws + WS_WT_IN), S_, NPROJ, DM}; pg8::StaticOrder S; S.init(S_, NPROJ, G, bx);
        pg8::EpiProj E{(bf16_t*)(ws + WS_PROJ), NPROJ, C_GA, C_IK};
        pg8::gemm_phase<pg8::EpiProj, pg8::StaticOrder, PG8_ALIGN, PG8_SP2>(lds, g, S, E);
    }
    SEAM(P_PROJ);
    if (IN(P_TOPK)) {
#if DBG_TOPK
        for (int t = S_ - 1 - bx; t >= 0; t -= G) naive_topk_query<NWAVES * 64>(t, proj, (int*)(ws + WS_SELIDX2), (int*)(ws + WS_SELCNT2), (float*)lds_raw);
        __syncthreads();
#endif
        for (int i = bx; i < S_ / 32; i += G) { tk::topk_block(S_ / 16 - 1 - i, proj, (unsigned*)(ws + WS_MASK), lds, tid, lane, wave); tk::topk_block(i, proj, (unsigned*)(ws + WS_MASK), lds, tid, lane, wave); }
        xcd_barrier(bar);
        for (int t = vcu * NWAVES + wave; t < S_; t += G * NWAVES) mask_to_list_wave(t, (const unsigned*)(ws + WS_MASK), (int*)(ws + WS_SELIDX), (int*)(ws + WS_SELCNT), lane);
#if DBG_TOPK
        for (int t = vcu * NWAVES + wave; t < S_; t += G * NWAVES) list_compare_wave(t, (const int*)(ws + WS_SELIDX), (const int*)(ws + WS_SELCNT), (const int*)(ws + WS_SELIDX2), (const int*)(ws + WS_SELCNT2), ctl + 16, lane);
#endif
    }
    SEAM(P_TOPK);
    if (IN(P_ATTN)) {
        for (int t = S_ - 1 - bx; t >= 0; t -= G) naive_attn_a_wave(t, wave, proj, (const int*)(ws + WS_SELIDX), (const int*)(ws + WS_SELCNT), (bf16*)(ws + WS_OA), (float*)(lds_raw + wave * 4096), lane);
        for (int tp = bx; tp < S_ / 2; tp += G) naive_attn_b_wave(2 * tp + (wave >> 2), wave & 3, proj, (bf16*)(ws + WS_OB), (float*)(lds_raw + wave * 4096), lane);
    }
    SEAM(P_ATTN);
    if (IN(P_MERGE)) {
        { pg8::Gemm g{(const bf16_t*)(ws + WS_OA), (const bf16_t*)(ws + WS_WT_A), S_, DM, 1024}; pg8::StaticOrder S; S.init(S_, DM, G, bx);
          pg8::EpiMerge<1> E{(const bf16_t*)(ws + WS_PROJ), NPROJ, C_GA, out, DM, nullptr, 0};
          pg8::gemm_phase<pg8::EpiMerge<1>, pg8::StaticOrder, PG8_ALIGN, PG8_SP2>(lds, g, S, E); }
        { pg8::Gemm g{(const bf16_t*)(ws + WS_OB), (const bf16_t*)(ws + WS_WT_B), S_, DM, 512}; pg8::StaticOrder S; S.init(S_, DM, G, bx);
          pg8::EpiMerge<2> E{(const bf16_t*)(ws + WS_PROJ), NPROJ, C_GB, out, DM, (bf16_t*)(ws + WS_MERGED), DM};
          pg8::gemm_phase<pg8::EpiMerge<2>, pg8::StaticOrder, PG8_ALIGN, PG8_SP2>(lds, g, S, E); }
    }
    SEAM(P_MERGE);
    if (IN(P_WOUT)) {
        pg8::Gemm g{(const bf16_t*)(ws + WS_MERGED), (const bf16_t*)(ws + WS_WT_OUT), S_, DM, DM}; pg8::StaticOrder S; S.init(S_, DM, G, bx);
        pg8::EpiRes E{x, (float*)(ws + WS_H), DM, ALPHA};
        pg8::gemm_phase<pg8::EpiRes, pg8::StaticOrder, PG8_ALIGN, PG8_SP2>(lds, g, S, E);
    }
    SEAM(P_WOUT);
    if (IN(P_LN1)) { for (int row = vcu * NWAVES + wave; row < S_; row += G * NWAVES) ln_row((const float*)(ws + WS_H), args.in[5], args.in[6], (float*)(ws + WS_H), (bf16*)(ws + WS_HB), row, lane); }
    SEAM(P_LN1);
    if (IN(P_GU)) {
        pg8::Gemm g{(const bf16_t*)(ws + WS_HB), (const bf16_t*)(ws + WS_WT_GU), S_, NGU, DM}; pg8::StaticOrder S; S.init(S_, NGU, G, bx);
        pg8::EpiSwiGLU E{(bf16_t*)(ws + WS_ACT), DFF};
        pg8::gemm_phase<pg8::EpiSwiGLU, pg8::StaticOrder, PG8_ALIGN, PG8_SP2>(lds, g, S, E);
    }
    SEAM(P_GU);
    if (IN(P_DOWN)) {
        pg8::Gemm g{(const bf16_t*)(ws + WS_ACT), (const bf16_t*)(ws + WS_WT_DOWN), S_, DM, DFF}; pg8::StaticOrder S; S.init(S_, DM, G, bx);
        pg8::EpiRes E{(const float*)(ws + WS_H), out, DM, ALPHA};
        pg8::gemm_phase<pg8::EpiRes, pg8::StaticOrder, PG8_ALIGN, PG8_SP2>(lds, g, S, E);
    }
    SEAM(P_DOWN);
    if (IN(P_LN2)) { for (int row = vcu * NWAVES + wave; row < S_; row += G * NWAVES) ln_row(out, args.in[10], args.in[11], out, (bf16*)nullptr, row, lane); }
#if DBG_ANY
    if (IN(P_LN2) && vcu == 0 && tid == 0) {
        asm volatile("s_waitcnt vmcnt(0)" ::: "memory");
        const float cntf = (float)__hip_atomic_load(ctl + 16, __ATOMIC_RELAXED, __HIP_MEMORY_SCOPE_AGENT); const float mx = __uint_as_float(__hip_atomic_load(ctl + 17, __ATOMIC_RELAXED, __HIP_MEMORY_SCOPE_AGENT));
        out[0] += 4096.f * sqrtf(cntf + mx);
    }
#endif
#undef IN
#undef SEAM
}

#ifndef MK_CUTS
#define MK_CUTS {0, NPH}
#endif
extern "C" void kernel_launch(void* const* d_in, const int* in_sizes, int n_in, void* d_out, int out_size, void* d_ws, size_t ws_size, hipStream_t stream) {
    static int grid = 0;
    if (grid == 0) {
        if (n_in != 12 || in_sizes[0] != S_ * DM || out_size != S_ * DM || ws_size < WS_END) { fprintf(stderr, "kernel_launch: unexpected shapes / workspace (n_in %d, in0 %d, out %d, ws %zu)\n", n_in, n_in > 0 ? in_sizes[0] : -1, out_size, ws_size); grid = -1; return; }
        int dev = 0, cus = 0, per_cu = 0;
        if (hipGetDevice(&dev) != hipSuccess || hipDeviceGetAttribute(&cus, hipDeviceAttributeMultiprocessorCount, dev) != hipSuccess) { grid = -1; return; }
        if (hipFuncSetAttribute((const void*)mega_kernel, hipFuncAttributeMaxDynamicSharedMemorySize, LDS_BYTES) != hipSuccess) { fprintf(stderr, "kernel_launch: hipFuncSetAttribute failed\n"); grid = -1; return; }
        if (hipOccupancyMaxActiveBlocksPerMultiprocessor(&per_cu, (const void*)mega_kernel, NWAVES * 64, LDS_BYTES) != hipSuccess || per_cu < 1) { fprintf(stderr, "kernel_launch: occupancy query says %d workgroups per CU\n", per_cu); (void)hipGetLastError(); grid = -1; return; }
        grid = cus;
    }
    if (grid < 0) return;
    if (hipMemsetAsync((char*)d_ws + WS_CTL, 0, CTL_ZERO_BYTES, stream) != hipSuccess) return;
    Args a{};
    for (int i = 0; i < 12; ++i) a.in[i] = (const float*)d_in[i];
    a.out = (float*)d_out; a.ws = (unsigned char*)d_ws;
    const int cuts[] = MK_CUTS; const int nl = (int)(sizeof(cuts) / sizeof(int)) - 1;
    for (int li = 0; li < nl; ++li) { a.ph_lo = cuts[li]; a.ph_hi = cuts[li + 1]; a.li = li;
        hipLaunchKernelGGL(mega_kernel, dim3(grid), dim3(NWAVES * 64), LDS_BYTES, stream, a); }
}
```

```cpp
#include <hip/hip_runtime.h>
#include <cstdio>
#include <cstdint>
#ifndef DBG_TOPK
#define DBG_TOPK 0
#endif
#ifndef DBG_ATTN
#define DBG_ATTN 0
#endif
#ifndef NAIVE_ATTN
#define NAIVE_ATTN 0
#endif
#ifndef DBG_BSEL
#define DBG_BSEL 1.0f
#endif
#define DBG_ANY (DBG_TOPK || DBG_ATTN)
namespace pg8 {
#define PG8_LAS __attribute__((address_space(3)))
typedef unsigned short bf16_t;
typedef short bf16x8 __attribute__((ext_vector_type(8)));
typedef float f32x4 __attribute__((ext_vector_type(4)));
typedef unsigned u32x4 __attribute__((ext_vector_type(4)));
constexpr int BM = 256, BK = 64, HALF = 128, HTB = HALF * BK * 2  , STAGE_BYTES = 8 * HTB, NXCD = 8, WGM = 8;

__host__ __device__ __forceinline__ int lds_byte(int r, int c) { const int st = (r >> 4) * 2 + (c >> 5), rr = r & 15, cc = c & 31, ob = rr * 64 + cc * 2; return st * 1024 + (ob ^ (((ob >> 9) & 1) << 5)); }
__host__ __device__ __forceinline__ void stage_rc(int b, int& R, int& C) { const int st = b / 1024, sb = b % 1024, swz = sb ^ (((sb >> 9) & 1) << 5); R = (st >> 1) * 16 + swz / 64; C = (st & 1) * 32 + (swz % 64) / 2; }
__host__ __device__ __forceinline__ int perm32(int rho) { const int n = rho >> 4, i = rho & 15; return 8 * (i >> 2) + 4 * n + (i & 3); }

struct Unit { int pm, pn; };
struct Gemm { const bf16_t* A; const bf16_t* Bt; int M, N, K; };

struct StaticOrder {
    int nM, nN, nwg, G, c;
    __host__ __device__ void init(int M, int N, int G_, int c_) { nM = M / BM; nN = N / BM; nwg = nM * nN; G = G_; c = c_; }
    __host__ __device__ bool next(int i, Unit& u) const {
        const long L = (long)i * G + c; if (L >= nwg) return false;
        int wgid = (int)L; { const int q = nwg / NXCD, r = nwg % NXCD, xcd = wgid % NXCD, off = wgid / NXCD; wgid = (xcd < r ? xcd * (q + 1) : r * (q + 1) + (xcd - r) * q) + off; }
        const int nig = WGM * nN, gid = wgid / nig, fm = gid * WGM, gsz = (nM - fm) < WGM ? (nM - fm) : WGM;
        u.pm = fm + ((wgid % nig) % gsz); u.pn = (wgid % nig) / gsz; return true;
    }
    __device__ __forceinline__ void a_ready(const Unit&) const {}
    __device__ __forceinline__ void done(const Unit&) const {}
};

__device__ __forceinline__ unsigned cvt_pk_bf16(float lo, float hi) { unsigned r; asm volatile("v_cvt_pk_bf16_f32 %0, %1, %2" : "=v"(r) : "v"(lo), "v"(hi)); return r; }
__device__ __forceinline__ float bf_lo(unsigned w) { return __uint_as_float(w << 16); }
__device__ __forceinline__ float bf_hi(unsigned w) { return __uint_as_float(w & 0xffff0000u); }
__device__ __forceinline__ float sigmoidf_fast(float v) { return __builtin_amdgcn_rcpf(1.0f + __builtin_amdgcn_exp2f(-1.4426950408889634f * v)); }

struct EpiProj {
    static constexpr bool PERM = true, AFTER_DRAIN = false;
    bf16_t* O; int ldc; int sig_lo, sig_hi;
    __device__ __forceinline__ void operator()(const f32x4 (&acc)[2][2][4][2], const Unit& u, int wr, int wc, int fr, int fq) const {
        const int row0 = u.pm * BM + wr * 64 + fr; const int colt = u.pn * BM; const bool sg = colt >= sig_lo && colt < sig_hi;
        const int col0 = colt + wc * 32 + 8 * fq;
#pragma unroll
        for (int ai = 0; ai < 2; ++ai)
#pragma unroll
            for (int m = 0; m < 4; ++m) { bf16_t* rowp = O + (size_t)(row0 + ai * HALF + m * 16) * ldc + col0;
#pragma unroll
                for (int bj = 0; bj < 2; ++bj) { f32x4 v0 = acc[ai][bj][m][0], v1 = acc[ai][bj][m][1];
                    if (sg) {
#pragma unroll
                        for (int e = 0; e < 4; ++e) { v0[e] = sigmoidf_fast(v0[e]); v1[e] = sigmoidf_fast(v1[e]); } }
                    u32x4 w; w.x = cvt_pk_bf16(v0[0], v0[1]); w.y = cvt_pk_bf16(v0[2], v0[3]); w.z = cvt_pk_bf16(v1[0], v1[1]); w.w = cvt_pk_bf16(v1[2], v1[3]);
                    *(u32x4*)(rowp + bj * HALF) = w; } }
    }
};
template <int PART> struct EpiMerge {
    static constexpr bool PERM = true, AFTER_DRAIN = false;
    const bf16_t* G; int ldg; int gcol; float* T; int ldt; bf16_t* O; int ldo;
    __device__ __forceinline__ void operator()(const f32x4 (&acc)[2][2][4][2], const Unit& u, int wr, int wc, int fr, int fq) const {
        const int row0 = u.pm * BM + wr * 64 + fr; const int col0 = u.pn * BM + wc * 32 + 8 * fq;
#pragma unroll
        for (int ai = 0; ai < 2; ++ai)
#pragma unroll
            for (int m = 0; m < 4; ++m) { const size_t row = (size_t)(row0 + ai * HALF + m * 16);
#pragma unroll
                for (int bj = 0; bj < 2; ++bj) { const int col = col0 + bj * HALF;
                    const u32x4 gw = *(const u32x4*)(G + row * ldg + gcol + col);
                    f32x4 g0 = {bf_lo(gw.x), bf_hi(gw.x), bf_lo(gw.y), bf_hi(gw.y)}, g1 = {bf_lo(gw.z), bf_hi(gw.z), bf_lo(gw.w), bf_hi(gw.w)};
                    f32x4 v0 = acc[ai][bj][m][0] * g0, v1 = acc[ai][bj][m][1] * g1;
                    float* tp = T + row * ldt + col;
                    if (PART == 1) { *(f32x4*)tp = v0; *(f32x4*)(tp + 4) = v1; }
                    else { v0 = v0 + *(const f32x4*)tp; v1 = v1 + *(const f32x4*)(tp + 4);
                        u32x4 w; w.x = cvt_pk_bf16(v0[0], v0[1]); w.y = cvt_pk_bf16(v0[2], v0[3]); w.z = cvt_pk_bf16(v1[0], v1[1]); w.w = cvt_pk_bf16(v1[2], v1[3]);
                        *(u32x4*)(O + row * ldo + col) = w; } } }
    }
};
struct EpiRes {
    static constexpr bool PERM = false, AFTER_DRAIN = false;
    const float* R; float* Y; int ldc; float alpha;
    __device__ __forceinline__ void operator()(const f32x4 (&acc)[2][2][4][2], const Unit& u, int wr, int wc, int fr, int fq) const {
        const int row0 = u.pm * BM + wr * 64 + fr, col0 = u.pn * BM + wc * 32 + 4 * fq;
#pragma unroll
        for (int ai = 0; ai < 2; ++ai)
#pragma unroll
            for (int m = 0; m < 4; ++m) { const size_t off = (size_t)(row0 + ai * HALF + m * 16) * ldc + col0;
#pragma unroll
                for (int bj = 0; bj < 2; ++bj)
#pragma unroll
                    for (int n = 0; n < 2; ++n) { const f32x4 r = *(const f32x4*)(R + off + bj * HALF + n * 16); *(f32x4*)(Y + off + bj * HALF + n * 16) = r * alpha + acc[ai][bj][m][n]; } }
    }
};
struct EpiSwiGLU {
    static constexpr bool PERM = true, AFTER_DRAIN = false;
    bf16_t* O; int ldc;
    __device__ __forceinline__ void operator()(const f32x4 (&acc)[2][2][4][2], const Unit& u, int wr, int wc, int fr, int fq) const {
        const int row0 = u.pm * BM + wr * 64 + fr; const int col0 = u.pn * HALF + wc * 32 + 8 * fq;
#pragma unroll
        for (int ai = 0; ai < 2; ++ai)
#pragma unroll
            for (int m = 0; m < 4; ++m) { f32x4 g0 = acc[ai][0][m][0], g1 = acc[ai][0][m][1]; const f32x4 u0 = acc[ai][1][m][0], u1 = acc[ai][1][m][1];
#pragma unroll
                for (int e = 0; e < 4; ++e) { g0[e] = g0[e] * sigmoidf_fast(g0[e]) * u0[e]; g1[e] = g1[e] * sigmoidf_fast(g1[e]) * u1[e]; }
                u32x4 w; w.x = cvt_pk_bf16(g0[0], g0[1]); w.y = cvt_pk_bf16(g0[2], g0[3]); w.z = cvt_pk_bf16(g1[0], g1[1]); w.w = cvt_pk_bf16(g1[2], g1[3]);
                *(u32x4*)(O + (size_t)(row0 + ai * HALF + m * 16) * ldc + col0) = w; }
    }
};

template <class Epi, class Sched, bool ALIGN_EPI = false, bool SP2 = false>
__device__ __forceinline__ void gemm_phase(PG8_LAS unsigned char* lds, const Gemm g, const Sched& S, const Epi& E) {
    const int tid = threadIdx.x, wid = __builtin_amdgcn_readfirstlane(tid >> 6), lane = tid & 63, wr = wid >> 2, wc = wid & 3, fr = lane & 15, fq = lane >> 4;
    const int K = g.K, nt = K / BK;
    unsigned voffA[2], voffB[2];
#pragma unroll
    for (int i = 0; i < 2; ++i) { int R, C; stage_rc(tid * 16 + i * 8192, R, C); const int Rb = Epi::PERM ? ((R & ~31) + perm32(R & 31)) : R;
        voffA[i] = (unsigned)(R * K + C) * 2u; voffB[i] = (unsigned)(Rb * K + C) * 2u; }
    const size_t kstep = (size_t)(BK * 2);
    const size_t hstep = (size_t)HALF * K * 2;
    const size_t tstep = 2 * hstep;
    const unsigned ldsw = (unsigned)wid * 1024u;
    const int aoff = lds_byte(wr * 64 + fr, fq * 8), boff = lds_byte(wc * 32 + fr, fq * 8);
#define PG8_SA(b, h) (((b) * 2 + (h)) * HTB)
#define PG8_SB(b, h) ((4 + (b) * 2 + (h)) * HTB)
#define PG8_STAGE(bufoff, gbase, voff) do { _Pragma("unroll") for (int _i = 0; _i < 2; ++_i) \
        __builtin_amdgcn_global_load_lds((const unsigned*)((const char*)(gbase) + (voff)[_i]), (PG8_LAS unsigned*)(lds + (bufoff) + ldsw + _i * 8192), 16, 0, 0); } while (0)
#define PG8_LDA(dst, b, h) do { _Pragma("unroll") for (int m = 0; m < 4; ++m) _Pragma("unroll") for (int k = 0; k < 2; ++k) dst[m][k] = *(const PG8_LAS bf16x8*)(lds + PG8_SA(b, h) + aoff + m * 2048 + k * 1024); } while (0)
#define PG8_LDB(dst, b, h) do { _Pragma("unroll") for (int n = 0; n < 2; ++n) _Pragma("unroll") for (int k = 0; k < 2; ++k) dst[n][k] = *(const PG8_LAS bf16x8*)(lds + PG8_SB(b, h) + boff + n * 2048 + k * 1024); } while (0)
#define PG8_MMA(ai, bj, At, Bt) do { __builtin_amdgcn_s_setprio(1); _Pragma("unroll") for (int m = 0; m < 4; ++m) _Pragma("unroll") for (int n = 0; n < 2; ++n) _Pragma("unroll") for (int k = 0; k < 2; ++k) \
        acc[ai][bj][m][n] = __builtin_amdgcn_mfma_f32_16x16x32_bf16(Bt[n][k], At[m][k], acc[ai][bj][m][n], 0, 0, 0); __builtin_amdgcn_s_setprio(0); } while (0)
#define PG8_WAIT_V(n) asm volatile("s_waitcnt vmcnt(" #n ")" ::: "memory")
#define PG8_WAIT_L(n) asm volatile("s_waitcnt lgkmcnt(" #n ")" ::: "memory")
#define PG8_BAR __builtin_amdgcn_s_barrier()
#define PG8_SCHED __builtin_amdgcn_sched_barrier(0)
    Unit cur, nxt; int ui = 0;
    if (!S.next(0, cur)) return;
    f32x4 acc[2][2][4][2];
#pragma unroll
    for (int a = 0; a < 2; ++a)
#pragma unroll
        for (int b = 0; b < 2; ++b)
#pragma unroll
            for (int m = 0; m < 4; ++m)
#pragma unroll
                for (int n = 0; n < 2; ++n) acc[a][b][m][n] = (f32x4){0.f, 0.f, 0.f, 0.f};
    bf16x8 At[4][2], B0[2][2], B1[2][2];
    const char* cA = (const char*)g.A + (size_t)cur.pm * tstep; const char* cB = (const char*)g.Bt + (size_t)cur.pn * tstep;
    S.a_ready(cur);
    if constexpr (SP2) {
        PG8_STAGE(PG8_SB(0, 0), cB, voffB); PG8_STAGE(PG8_SB(0, 1), cB + hstep, voffB); PG8_STAGE(PG8_SA(0, 0), cA, voffA); PG8_STAGE(PG8_SA(0, 1), cA + hstep, voffA);
        if (wr == 1) PG8_BAR;
        PG8_WAIT_V(2); PG8_BAR;
        PG8_STAGE(PG8_SB(1, 0), cB + kstep, voffB); PG8_STAGE(PG8_SA(1, 0), cA + kstep, voffA); PG8_STAGE(PG8_SB(1, 1), cB + hstep + kstep, voffB);
        PG8_WAIT_V(6); PG8_BAR;
    } else {
        PG8_STAGE(PG8_SB(0, 0), cB, voffB); PG8_STAGE(PG8_SA(0, 0), cA, voffA); PG8_STAGE(PG8_SB(0, 1), cB + hstep, voffB); PG8_STAGE(PG8_SA(0, 1), cA + hstep, voffA);
        if (wr == 1) PG8_BAR;
        PG8_WAIT_V(4); PG8_BAR;
        PG8_STAGE(PG8_SB(1, 0), cB + kstep, voffB); PG8_STAGE(PG8_SA(1, 0), cA + kstep, voffA); PG8_STAGE(PG8_SB(1, 1), cB + hstep + kstep, voffB);
        PG8_WAIT_V(6); PG8_BAR;
    }
    for (;;) {
        const bool has_next = S.next(ui + 1, nxt);
        const char* nA = has_next ? (const char*)g.A + (size_t)nxt.pm * tstep : cA; const char* nB = has_next ? (const char*)g.Bt + (size_t)nxt.pn * tstep : cB;
        for (int t = 0; t < nt; t += 2) {
            const bool last = (t == nt - 2);
            const char* a1 = cA + (size_t)(t + 1) * kstep;
            const char* a2 = last ? nA : cA + (size_t)(t + 2) * kstep; const char* b2 = last ? nB : cB + (size_t)(t + 2) * kstep;
            const char* a3 = a2 + kstep; const char* b3 = b2 + kstep;
            if (last && has_next) S.a_ready(nxt);
            if constexpr (SP2) {
            PG8_LDB(B0, 0, 0); PG8_LDB(B1, 0, 1); PG8_SCHED; PG8_LDA(At, 0, 0); PG8_STAGE(PG8_SA(1, 1), a1 + hstep, voffA);
            PG8_WAIT_V(8); PG8_WAIT_L(0); PG8_BAR; PG8_MMA(0, 0, At, B0); PG8_MMA(0, 1, At, B1); PG8_BAR; PG8_SCHED;
            PG8_LDA(At, 0, 1); PG8_STAGE(PG8_SB(0, 0), b2, voffB); PG8_STAGE(PG8_SB(0, 1), b2 + hstep, voffB); PG8_STAGE(PG8_SA(0, 0), a2, voffA);
            PG8_WAIT_V(8); PG8_WAIT_L(0); PG8_BAR; PG8_MMA(1, 0, At, B0); PG8_MMA(1, 1, At, B1); PG8_BAR; PG8_SCHED;
            PG8_LDB(B0, 1, 0); PG8_LDB(B1, 1, 1); PG8_SCHED; PG8_LDA(At, 1, 0); PG8_STAGE(PG8_SA(0, 1), a2 + hstep, voffA);
            PG8_WAIT_V(8); PG8_WAIT_L(0); PG8_BAR; PG8_MMA(0, 0, At, B0); PG8_MMA(0, 1, At, B1); PG8_BAR; PG8_SCHED;
            PG8_LDA(At, 1, 1); PG8_STAGE(PG8_SB(1, 0), b3, voffB); PG8_STAGE(PG8_SB(1, 1), b3 + hstep, voffB); PG8_STAGE(PG8_SA(1, 0), a3, voffA);
            PG8_WAIT_V(8); PG8_WAIT_L(0); PG8_BAR; PG8_MMA(1, 0, At, B0); PG8_MMA(1, 1, At, B1); PG8_BAR; PG8_SCHED;
            } else {
            PG8_LDB(B0, 0, 0); PG8_SCHED; PG8_LDA(At, 0, 0); PG8_STAGE(PG8_SA(1, 1), a1 + hstep, voffA);
            PG8_WAIT_L(8); PG8_BAR; PG8_WAIT_L(0); PG8_MMA(0, 0, At, B0); PG8_BAR; PG8_SCHED;
            PG8_LDB(B1, 0, 1); PG8_STAGE(PG8_SB(0, 0), b2, voffB);
            PG8_BAR; PG8_WAIT_L(0); PG8_MMA(0, 1, At, B1); PG8_BAR;
            PG8_LDA(At, 0, 1); PG8_STAGE(PG8_SA(0, 0), a2, voffA);
            PG8_BAR; PG8_WAIT_L(0); PG8_MMA(1, 0, At, B0); PG8_BAR; PG8_SCHED;
            PG8_STAGE(PG8_SB(0, 1), b2 + hstep, voffB);
            PG8_WAIT_V(6); PG8_BAR; PG8_MMA(1, 1, At, B1); PG8_BAR;
            PG8_LDB(B0, 1, 0); PG8_SCHED; PG8_LDA(At, 1, 0); PG8_STAGE(PG8_SA(0, 1), a2 + hstep, voffA);
            PG8_WAIT_L(8); PG8_BAR; PG8_WAIT_L(0); PG8_MMA(0, 0, At, B0); PG8_BAR; PG8_SCHED;
            PG8_LDB(B1, 1, 1); PG8_STAGE(PG8_SB(1, 0), b3, voffB);
            PG8_BAR; PG8_WAIT_L(0); PG8_MMA(0, 1, At, B1); PG8_BAR;
            PG8_LDA(At, 1, 1); PG8_STAGE(PG8_SA(1, 0), a3, voffA);
            PG8_BAR; PG8_WAIT_L(0); PG8_MMA(1, 0, At, B0); PG8_BAR; PG8_SCHED;
            PG8_STAGE(PG8_SB(1, 1), b3 + hstep, voffB);
            PG8_WAIT_V(6); PG8_BAR; PG8_MMA(1, 1, At, B1); PG8_BAR;
            }
        }
        if constexpr (ALIGN_EPI) { if (wr == 0) PG8_BAR; }
        if constexpr (!Epi::AFTER_DRAIN) { E(acc, cur, wr, wc, fr, fq); S.done(cur); }
        if (!has_next) break;
#pragma unroll
        for (int a = 0; a < 2; ++a)
#pragma unroll
            for (int b = 0; b < 2; ++b)
#pragma unroll
                for (int m = 0; m < 4; ++m)
#pragma unroll
                    for (int n = 0; n < 2; ++n) acc[a][b][m][n] = (f32x4){0.f, 0.f, 0.f, 0.f};
        cur = nxt; cA = nA; cB = nB; ++ui;
        if constexpr (ALIGN_EPI) { if (wr == 1) PG8_BAR; }
    }
    PG8_WAIT_V(0);
    if constexpr (!ALIGN_EPI) { if (wr == 0) PG8_BAR; }
    PG8_BAR;
    if constexpr (Epi::AFTER_DRAIN) { E.fused(acc, cur, wr, wc, fr, fq, lds, wid, lane); S.done(cur); }
#undef PG8_SA
#undef PG8_SB
#undef PG8_STAGE
#undef PG8_LDA
#undef PG8_LDB
#undef PG8_MMA
#undef PG8_WAIT_V
#undef PG8_WAIT_L
#undef PG8_BAR
#undef PG8_SCHED
}
}
#ifndef PG8_SP2
#define PG8_SP2 true
#endif
#ifndef PG8_ALIGN
#define PG8_ALIGN true
#endif
constexpr int S_ = 8192, DM = 2048, DFF = 5632, NPROJ = 13056, NGU = 2 * DFF;
constexpr int IN_W = 12880;
constexpr int C_AQ = 0, C_AK = 1024, C_AV = 2048, C_IQ = 3072, C_BQ = 4096, C_BK = 5632, C_BV = 7168, C_GA = 8704, C_GB = 10752, C_IK = 12800, C_IW = 12864;
constexpr float ALPHA = 1.189207115002721f;
constexpr float LN_EPS = 1e-5f;
constexpr int TOPK = 256;

constexpr size_t MiB = 1u << 20;
constexpr size_t WS_CTL = 0, CTL_ZERO_BYTES = 256 * 1024;
constexpr size_t WS_WT_IN = 1 * MiB, WS_WT_A = 52 * MiB, WS_WT_B = 56 * MiB, WS_WT_OUT = 58 * MiB, WS_WT_GU = 66 * MiB, WS_WT_DOWN = 110 * MiB;
constexpr size_t WS_XB = 132 * MiB, WS_MERGED = 132 * MiB;
constexpr size_t WS_PROJ = 164 * MiB;
constexpr size_t WS_OA = 1 * MiB, WS_OB = 17 * MiB, WS_MASK = 25 * MiB, WS_SELCNT = 33 * MiB, WS_SELIDX = 34 * MiB, WS_OPA2 = 42 * MiB, WS_LSEA = 50 * MiB, WS_LSEB = 51 * MiB;
constexpr size_t WS_SELIDX2 = 42 * MiB, WS_SELCNT2 = 50 * MiB;
constexpr size_t WS_OPA0 = 132 * MiB, WS_OPA1 = 148 * MiB, WS_OPA3 = 160 * MiB;
constexpr size_t WS_OPB = 368 * MiB;
constexpr size_t WS_H = 164 * MiB, WS_HB = 228 * MiB, WS_ACT = 260 * MiB;
constexpr size_t WS_END = 392 * MiB;
static_assert(WS_WT_IN + (size_t)NPROJ * DM * 2 <= WS_WT_A && WS_WT_GU + (size_t)NGU * DM * 2 <= WS_WT_DOWN && WS_WT_DOWN + (size_t)DM * DFF * 2 <= WS_XB, "ws map 1");
static_assert(WS_PROJ + (size_t)S_ * NPROJ * 2 <= WS_OPB && WS_ACT + (size_t)S_ * DFF * 2 <= WS_OPB && WS_LSEB + 1 * MiB <= WS_WT_A, "ws map 2");

#define GAS __attribute__((address_space(1)))
#define LAS __attribute__((address_space(3)))
typedef unsigned short bf16;
typedef unsigned v4u __attribute__((ext_vector_type(4)));
typedef float f32x4 __attribute__((ext_vector_type(4)));
__device__ __forceinline__ unsigned f2bf(float f) { unsigned u = __builtin_bit_cast(unsigned, f); return (u + 0x7fffu + ((u >> 16) & 1u)) >> 16; }
__device__ __forceinline__ unsigned pk2(float lo, float hi) { return f2bf(lo) | (f2bf(hi) << 16); }
__device__ __forceinline__ float bf2f(bf16 v) { return __uint_as_float((unsigned)v << 16); }
__device__ __forceinline__ float wave_sum(float v) {
#pragma unroll
    for (int o = 1; o < 64; o <<= 1) v += __shfl_xor(v, o);
    return v;
}
__device__ __forceinline__ float wave_max(float v) {
#pragma unroll
    for (int o = 1; o < 64; o <<= 1) v = fmaxf(v, __shfl_xor(v, o));
    return v;
}

__device__ __forceinline__ void transpose_item(const float* W, int Nsrc, int K, bf16* WT, int n0, int k0, int srccol0, int nvalid, float* scr, int lane) {
#pragma unroll 8
    for (int i = 0; i < 32; ++i) { const int kk = 2 * i + (lane >> 5); const int c = lane & 31;
        scr[kk * 33 + c] = (c < nvalid) ? W[(size_t)(k0 + kk) * Nsrc + srccol0 + c] : 0.f; }
    __builtin_amdgcn_s_waitcnt(0xc07f); asm volatile("" ::: "memory");
    const int c = lane & 7;
#pragma unroll
    for (int j = 0; j < 4; ++j) { const int n = (lane >> 3) + 8 * j; const float* s = scr + (8 * c) * 33 + n;
        v4u o; o.x = pk2(s[0 * 33], s[1 * 33]); o.y = pk2(s[2 * 33], s[3 * 33]); o.z = pk2(s[4 * 33], s[5 * 33]); o.w = pk2(s[6 * 33], s[7 * 33]);
        *(v4u*)(WT + (size_t)(n0 + n) * K + k0 + 8 * c) = o; }
    __builtin_amdgcn_s_waitcnt(0xc07f); asm volatile("" ::: "memory");
}
struct ProArgs { const float *x, *w_in, *w_a, *w_b, *w_out, *w_gate, *w_up, *w_down; unsigned char* ws; };
__device__ __forceinline__ void prologue_body(const ProArgs& a, float* scr  , int gw, int NGW, int lane) {
    bf16* wt_in = (bf16*)(a.ws + WS_WT_IN); bf16* wt_a = (bf16*)(a.ws + WS_WT_A); bf16* wt_b = (bf16*)(a.ws + WS_WT_B); bf16* wt_out = (bf16*)(a.ws + WS_WT_OUT);
    bf16* wt_gu = (bf16*)(a.ws + WS_WT_GU); bf16* wt_down = (bf16*)(a.ws + WS_WT_DOWN); bf16* xb = (bf16*)(a.ws + WS_XB);
    constexpr int I_IN = (DM / 64) * (NPROJ / 32), I_A = (1024 / 64) * (DM / 32), I_B = (512 / 64) * (DM / 32), I_OUT = (DM / 64) * (DM / 32), I_GU = (DM / 64) * (NGU / 32), I_DN = (DFF / 64) * (DM / 32);
    constexpr int NITEMS = I_IN + I_A + I_B + I_OUT + I_GU + I_DN;
    for (int it = gw; it < NITEMS; it += NGW) {
        int r = it;
        if (r < I_IN) { const int nb = r % (NPROJ / 32), kb = r / (NPROJ / 32), n0 = nb * 32;
            int src, nv = 32;
            if (n0 < 4096) src = n0; else if (n0 < 12800) src = n0 + 80; else if (n0 < 12880) { src = n0 - 12800 + 4096; nv = (12880 - n0) < 32 ? (12880 - n0) : 32; } else { src = 0; nv = 0; }
            transpose_item(a.w_in, IN_W, DM, wt_in, n0, kb * 64, src, nv, scr, lane); continue; }
        r -= I_IN;
        if (r < I_A) { const int nb = r % (DM / 32), kb = r / (DM / 32); transpose_item(a.w_a, DM, 1024, wt_a, nb * 32, kb * 64, nb * 32, 32, scr, lane); continue; }
        r -= I_A;
        if (r < I_B) { const int nb = r % (DM / 32), kb = r / (DM / 32); transpose_item(a.w_b, DM, 512, wt_b, nb * 32, kb * 64, nb * 32, 32, scr, lane); continue; }
        r -= I_B;
        if (r < I_OUT) { const int nb = r % (DM / 32), kb = r / (DM / 32); transpose_item(a.w_out, DM, DM, wt_out, nb * 32, kb * 64, nb * 32, 32, scr, lane); continue; }
        r -= I_OUT;
        if (r < I_GU) { const int nb = r % (NGU / 32), kb = r / (NGU / 32), n0 = nb * 32; const int half = (n0 >> 7) & 1, j = n0 >> 8, i = n0 & 127;
            transpose_item(half ? a.w_up : a.w_gate, DFF, DM, wt_gu, n0, kb * 64, 128 * j + i, 32, scr, lane); continue; }
        r -= I_GU;
        { const int nb = r % (DM / 32), kb = r / (DM / 32); transpose_item(a.w_down, DM, DFF, wt_down, nb * 32, kb * 64, nb * 32, 32, scr, lane); }
    }
    for (int m = gw; m < S_; m += NGW) {
        const f32x4* xr = (const f32x4*)(a.x + (size_t)m * DM) + lane; unsigned long long* o8 = (unsigned long long*)(xb + (size_t)m * DM) + lane;
#pragma unroll
        for (int j = 0; j < 8; ++j) { const f32x4 v = xr[64 * j]; o8[64 * j] = (unsigned long long)pk2(v.x, v.y) | ((unsigned long long)pk2(v.z, v.w) << 32); }
    }
}
__device__ __forceinline__ void ln_row(const float* Y, const float* g, const float* b, float* outf, bf16* outb, int row, int lane) {
    const f32x4* yr = (const f32x4*)(Y + (size_t)row * DM) + lane;
    f32x4 v[8]; float s = 0.f;
#pragma unroll
    for (int j = 0; j < 8; ++j) { v[j] = yr[64 * j]; s += (v[j].x + v[j].y) + (v[j].z + v[j].w); }
    const float mean = wave_sum(s) * (1.f / DM); float s2 = 0.f;
#pragma unroll
    for (int j = 0; j < 8; ++j) { v[j] = v[j] - mean; s2 += (v[j].x * v[j].x + v[j].y * v[j].y) + (v[j].z * v[j].z + v[j].w * v[j].w); }
    const float rstd = 1.f / sqrtf(wave_sum(s2) * (1.f / DM) + LN_EPS);
#pragma unroll
    for (int j = 0; j < 8; ++j) { const f32x4 gg = ((const f32x4*)g)[lane + 64 * j], bb = ((const f32x4*)b)[lane + 64 * j]; const f32x4 o = v[j] * rstd * gg + bb;
        ((f32x4*)(outf + (size_t)row * DM))[lane + 64 * j] = o;
        if (outb) ((unsigned long long*)(outb + (size_t)row * DM))[lane + 64 * j] = (unsigned long long)pk2(o.x, o.y) | ((unsigned long long)pk2(o.z, o.w) << 32); }
}

__device__ __forceinline__ unsigned ord_key(float f) { unsigned u = __float_as_uint(f); return (u & 0x80000000u) ? ~u : (u | 0x80000000u); }
template <int NT> __device__ __forceinline__ unsigned block_exscan(unsigned v, unsigned* sh, unsigned* tot) {
    const int lane = threadIdx.x & 63, w = threadIdx.x >> 6;
    unsigned inc = v;
#pragma unroll
    for (int o = 1; o < 64; o <<= 1) { unsigned t = __shfl_up(inc, o); if (lane >= o) inc += t; }
    __syncthreads();
    if (lane == 63) sh[w] = inc;
    __syncthreads();
    unsigned base = 0, total = 0;
#pragma unroll
    for (int i = 0; i < NT / 64; ++i) { const unsigned s = sh[i]; if (i < w) base += s; total += s; }
    *tot = total;
    return base + inc - v;
}
constexpr int NTK_LDS_BYTES = (8192 + 1024 + 16 + 256 + 8 + 8) * 4;
template <int NT> __device__ __forceinline__ void naive_topk_query(int t, const bf16* proj, int* sel_idx, int* sel_cnt, float* ldsf) {
    float* sc = ldsf; float* qs = sc + 8192; float* wsh = qs + 1024; unsigned* hist = (unsigned*)(wsh + 16); unsigned* shs = hist + 256; unsigned* shp = shs + 8;
    const int tid = threadIdx.x; const int n = t + 1;
    const bf16* prow = proj + (size_t)t * NPROJ;
    __syncthreads();
    for (int i = tid; i < 1024; i += NT) qs[i] = bf2f(prow[C_IQ + i]);
    if (tid < 16) wsh[tid] = bf2f(prow[C_IW + tid]) * 0.25f;
    __syncthreads();
    for (int s = tid; s < n; s += NT) {
        const bf16* kr = proj + (size_t)s * NPROJ + C_IK; float kf[64];
#pragma unroll
        for (int i = 0; i < 8; ++i) { const v4u w = ((const v4u*)kr)[i];
            kf[8 * i + 0] = __uint_as_float(w.x << 16); kf[8 * i + 1] = __uint_as_float(w.x & 0xffff0000u); kf[8 * i + 2] = __uint_as_float(w.y << 16); kf[8 * i + 3] = __uint_as_float(w.y & 0xffff0000u);
            kf[8 * i + 4] = __uint_as_float(w.z << 16); kf[8 * i + 5] = __uint_as_float(w.z & 0xffff0000u); kf[8 * i + 6] = __uint_as_float(w.w << 16); kf[8 * i + 7] = __uint_as_float(w.w & 0xffff0000u); }
        float score = 0.f;
        for (int h = 0; h < 16; ++h) { float d = 0.f;
#pragma unroll
            for (int i = 0; i < 64; ++i) d = fmaf(qs[h * 64 + i], kf[i], d);
            score = fmaf(wsh[h], fmaxf(d * 0.125f, 0.f), score); }
        sc[s] = score;
    }
    __syncthreads();
    int* out = sel_idx + (size_t)t * TOPK;
    if (n <= TOPK) { if (tid < TOPK) out[tid] = tid < n ? tid : -1; if (tid == 0) sel_cnt[t] = n; return; }
    if (tid == 0) { shp[0] = 0u; shp[1] = TOPK; }
    unsigned maskbits = 0u;
    for (int round = 0; round < 4; ++round) {
        const int shift = 24 - 8 * round;
        if (tid < 256) hist[tid] = 0u;
        __syncthreads();
        const unsigned prefix = shp[0];
        for (int s = tid; s < n; s += NT) { const unsigned k = ord_key(sc[s]); if ((k & maskbits) == prefix) atomicAdd(&hist[(k >> shift) & 255u], 1u); }
        __syncthreads();
        if (tid == 0) { unsigned r = shp[1], cum = 0; int b = 255; for (; b > 0; --b) { if (cum + hist[b] >= r) break; cum += hist[b]; } shp[1] = r - cum; shp[0] = prefix | ((unsigned)b << shift); }
        maskbits |= 255u << shift;
        __syncthreads();
    }
    const unsigned tau = shp[0]; const unsigned rt = shp[1];
    constexpr int CH = S_ / NT;
    const int s0 = tid * CH;
    unsigned nt = 0;
    for (int i = 0; i < CH; ++i) { const int s = s0 + i; if (s < n && ord_key(sc[s]) == tau) ++nt; }
    unsigned tot; unsigned tr = block_exscan<NT>(nt, shs, &tot);
    unsigned ns = 0; unsigned flags = 0;
    for (int i = 0; i < CH; ++i) { const int s = s0 + i; if (s < n) { const unsigned k = ord_key(sc[s]); bool sel = k > tau; if (k == tau) { sel = tr < rt; ++tr; } if (sel) { flags |= 1u << i; ++ns; } } }
    unsigned sbase = block_exscan<NT>(ns, shs, &tot);
    for (int i = 0; i < CH; ++i) if (flags & (1u << i)) out[sbase++] = s0 + i;
    if (tid == 0) sel_cnt[t] = (int)tot;
}
constexpr int NAA_LDS_WAVE = (128 + 256 + 256) * 4;
__device__ __forceinline__ void naive_attn_a_wave(int t, int h, const bf16* proj, const int* sel_idx, const int* sel_cnt, bf16* oa, float* ldsw, int lane, unsigned* chk = nullptr) {
    float* q = ldsw; float* pw = q + 128; int* sel = (int*)(pw + 256);
    const bf16* prow = proj + (size_t)t * NPROJ;
    for (int i = lane; i < 128; i += 64) q[i] = bf2f(prow[C_AQ + h * 128 + i]);
    for (int i = lane; i < 256; i += 64) sel[i] = sel_idx[(size_t)t * TOPK + i];
    const int cnt = sel_cnt[t];
    __builtin_amdgcn_s_waitcnt(0xc07f); asm volatile("" ::: "memory");
    const float slope = exp2f(-0.4f * (float)(13 + h));
    float lg[4]; float mx = -INFINITY;
#pragma unroll
    for (int i = 0; i < 4; ++i) { const int k = lane + 64 * i; lg[i] = -INFINITY;
        if (k < cnt) { const int s = sel[k]; const v4u* kr = (const v4u*)(proj + (size_t)s * NPROJ + C_AK + h * 128); float d = 0.f;
            for (int c = 0; c < 16; ++c) { const v4u wv = kr[c];
                d = fmaf(q[8 * c + 0], __uint_as_float(wv.x << 16), d); d = fmaf(q[8 * c + 1], __uint_as_float(wv.x & 0xffff0000u), d);
                d = fmaf(q[8 * c + 2], __uint_as_float(wv.y << 16), d); d = fmaf(q[8 * c + 3], __uint_as_float(wv.y & 0xffff0000u), d);
                d = fmaf(q[8 * c + 4], __uint_as_float(wv.z << 16), d); d = fmaf(q[8 * c + 5], __uint_as_float(wv.z & 0xffff0000u), d);
                d = fmaf(q[8 * c + 6], __uint_as_float(wv.w << 16), d); d = fmaf(q[8 * c + 7], __uint_as_float(wv.w & 0xffff0000u), d); }
            lg[i] = d * 0.08838834764831845f - slope * (float)(t - s); }
        mx = fmaxf(mx, lg[i]); }
    mx = wave_max(mx); float sum = 0.f;
#pragma unroll
    for (int i = 0; i < 4; ++i) { lg[i] = (lane + 64 * i < cnt) ? __expf(lg[i] - mx) : 0.f; sum += lg[i]; }
    sum = wave_sum(sum); const float inv = 1.f / sum;
#pragma unroll
    for (int i = 0; i < 4; ++i) pw[lane + 64 * i] = lg[i] * inv;
    __builtin_amdgcn_s_waitcnt(0xc07f); asm volatile("" ::: "memory");
    float o0 = 0.f, o1 = 0.f;
    for (int k = 0; k < cnt; ++k) { const int s = sel[k]; const unsigned vv = *(const unsigned*)(proj + (size_t)s * NPROJ + C_AV + h * 128 + 2 * lane); const float p = pw[k];
        o0 = fmaf(p, __uint_as_float(vv << 16), o0); o1 = fmaf(p, __uint_as_float(vv & 0xffff0000u), o1); }
    if (chk) { const unsigned got = *(const unsigned*)(oa + (size_t)t * 1024 + h * 128 + 2 * lane); const float df = fmaxf(fabsf(__uint_as_float(got << 16) - o0), fabsf(__uint_as_float(got & 0xffff0000u) - o1));
        atomicMax(chk, __float_as_uint(wave_max(df))); }
    else *(unsigned*)(oa + (size_t)t * 1024 + h * 128 + 2 * lane) = pk2(o0, o1);
    __builtin_amdgcn_s_waitcnt(0xc07f); asm volatile("" ::: "memory");
}
constexpr int NAB_LDS_WAVE = (384 + 388) * 4;
__device__ __forceinline__ void naive_attn_b_wave(int t, int j, const bf16* proj, bf16* ob, float* ldsw, int lane, unsigned* chk = nullptr) {
    float* qsh = ldsw; float* pw = qsh + 384;
    const bf16* prow = proj + (size_t)t * NPROJ;
    for (int g = 0; g < 3; ++g) for (int i = lane; i < 128; i += 64) qsh[g * 128 + i] = bf2f(prow[C_BQ + (4 * g + j) * 128 + i]);
    __builtin_amdgcn_s_waitcnt(0xc07f); asm volatile("" ::: "memory");
    float mx = -INFINITY;
    for (int g = 0; g < 3; ++g) { const int d = g == 0 ? 1 : (g == 1 ? 4 : 16); const int m = t / d; const int nk = (m < 128 ? m : 128) + 1; const int head = 4 * g + j;
        const float slope = exp2f(-0.4f * (float)(head + 1)); const float* q = qsh + g * 128;
        for (int i = lane; i < 129; i += 64) { float l = -INFINITY;
            if (i < nk) { const int s = t - i * d; const v4u* kr = (const v4u*)(proj + (size_t)s * NPROJ + C_BK + head * 128); float dd = 0.f;
                for (int c = 0; c < 16; ++c) { const v4u wv = kr[c];
                    dd = fmaf(q[8 * c + 0], __uint_as_float(wv.x << 16), dd); dd = fmaf(q[8 * c + 1], __uint_as_float(wv.x & 0xffff0000u), dd);
                    dd = fmaf(q[8 * c + 2], __uint_as_float(wv.y << 16), dd); dd = fmaf(q[8 * c + 3], __uint_as_float(wv.y & 0xffff0000u), dd);
                    dd = fmaf(q[8 * c + 4], __uint_as_float(wv.z << 16), dd); dd = fmaf(q[8 * c + 5], __uint_as_float(wv.z & 0xffff0000u), dd);
                    dd = fmaf(q[8 * c + 6], __uint_as_float(wv.w << 16), dd); dd = fmaf(q[8 * c + 7], __uint_as_float(wv.w & 0xffff0000u), dd); }
                l = dd * 0.08838834764831845f - slope * (float)(i * d); }
            pw[g * 129 + i] = l; mx = fmaxf(mx, l); } }
    mx = wave_max(mx);
    __builtin_amdgcn_s_waitcnt(0xc07f); asm volatile("" ::: "memory");
    float sum = 0.f;
    for (int i = lane; i < 387; i += 64) { const float p = __expf(pw[i] - mx); pw[i] = p; sum += p; }
    sum = wave_sum(sum); const float inv = 1.f / sum;
    __builtin_amdgcn_s_waitcnt(0xc07f); asm volatile("" ::: "memory");
    float o0 = 0.f, o1 = 0.f;
    for (int g = 0; g < 3; ++g) { const int d = g == 0 ? 1 : (g == 1 ? 4 : 16); const int m = t / d; const int nk = (m < 128 ? m : 128) + 1; const int head = 4 * g + j;
        for (int i = 0; i < nk; ++i) { const int s = t - i * d; const unsigned vv = *(const unsigned*)(proj + (size_t)s * NPROJ + C_BV + head * 128 + 2 * lane); const float p = pw[g * 129 + i];
            o0 = fmaf(p, __uint_as_float(vv << 16), o0); o1 = fmaf(p, __uint_as_float(vv & 0xffff0000u), o1); } }
    if (chk) { const unsigned got = *(const unsigned*)(ob + (size_t)t * 512 + j * 128 + 2 * lane); const float df = fmaxf(fabsf(__uint_as_float(got << 16) - o0 * inv), fabsf(__uint_as_float(got & 0xffff0000u) - o1 * inv));
        atomicMax(chk, __float_as_uint(wave_max(df))); }
    else *(unsigned*)(ob + (size_t)t * 512 + j * 128 + 2 * lane) = pk2(o0 * inv, o1 * inv);
    __builtin_amdgcn_s_waitcnt(0xc07f); asm volatile("" ::: "memory");
}

constexpr int NWAVES = 8;
constexpr int RING_BYTES = 131072;
constexpr int LDSCTL_OFF = RING_BYTES, MISC_OFF = LDSCTL_OFF + 320;
constexpr int LDS_BYTES = 147456;
constexpr int CW_TMO = 0, CW_BAR = 4096;
typedef GAS unsigned gu32;
#define RLX_AGENT __ATOMIC_RELAXED, __HIP_MEMORY_SCOPE_AGENT
namespace tk {
typedef short bf16x8 __attribute__((ext_vector_type(8)));
typedef float f32x16 __attribute__((ext_vector_type(16)));
constexpr int KT = 128, KT_BYTES = KT * 128, HIST_OFF = 2 * KT_BYTES, HIST_Q_BYTES = 4096, LDS_NEED = HIST_OFF + 16 * HIST_Q_BYTES;
constexpr int FLAG_OFF = 131072 + 320 + 64;
__device__ __forceinline__ int crow(int r, int hi) { return (r & 3) + 8 * (r >> 2) + 4 * hi; }
__device__ __forceinline__ unsigned okey(float f) { const unsigned u = __float_as_uint(f); return (u & 0x80000000u) ? ~u : (u | 0x80000000u); }
__device__ __forceinline__ float vmax0(float a) { return __builtin_amdgcn_fmed3f(a, 0.f, __builtin_inff()); }

struct Lane {
    bf16x8 af[4]; float wv[16]; unsigned koff[4]; int kperm; unsigned lower; int tq;
};
template <int MODE> __device__ __forceinline__ void pass(const Lane& L, const bf16* proj, unsigned* maskout, LAS unsigned char* lds, int nt, int tid, int lane, int wave,
                                                          unsigned prefix, unsigned mbits, int shift, unsigned bmask, bool act, unsigned tau, unsigned req, int t0) {
    const int hi = lane >> 5;
    LAS unsigned* hist = (LAS unsigned*)(lds + HIST_OFF + (wave * 2 + hi) * HIST_Q_BYTES);
    const int r0 = tid >> 3, c0 = tid & 7;
    const unsigned w0 = (unsigned)(r0 * 128 + 16 * (c0 ^ ((r0 >> 1) & 7))), w1 = (unsigned)((r0 + 64) * 128 + 16 * (c0 ^ (((r0 + 64) >> 1) & 7)));
    const bf16* g0 = proj + (size_t)r0 * NPROJ + C_IK + c0 * 8;
    v4u s0 = *(const v4u*)g0, s1 = *(const v4u*)(g0 + (size_t)64 * NPROJ);
    *(LAS v4u*)(lds + w0) = s0; *(LAS v4u*)(lds + w1) = s1;
    __syncthreads();
    unsigned run = 0;
    unsigned wq0h0 = 0, wq0h1 = 0, wq1h0 = 0, wq1h1 = 0;
    for (int i = 0; i < nt; ++i) {
        const bool more = (i + 1 < nt);
        if (more) { const bf16* g = g0 + (size_t)(i + 1) * KT * NPROJ; s0 = *(const v4u*)g; s1 = *(const v4u*)(g + (size_t)64 * NPROJ); }
        LAS unsigned char* buf = lds + (i & 1) * KT_BYTES;
#pragma unroll
        for (int j = 0; j < 4; ++j) {
            f32x16 c = {0.f, 0.f, 0.f, 0.f, 0.f, 0.f, 0.f, 0.f, 0.f, 0.f, 0.f, 0.f, 0.f, 0.f, 0.f, 0.f};
#pragma unroll
            for (int ks = 0; ks < 4; ++ks) { const bf16x8 kb = *(const LAS bf16x8*)(buf + L.koff[ks] + 4096 * j); c = __builtin_amdgcn_mfma_f32_32x32x16_bf16(L.af[ks], kb, c, 0, 0, 0); }
            float score = 0.f;
#pragma unroll
            for (int r = 0; r < 16; ++r) score = __builtin_fmaf(L.wv[r], vmax0(c[r]), score);
            const unsigned key = okey(score);
            const int s = i * KT + 32 * j + L.kperm;
            const bool valid = s <= L.tq;
            if (MODE == 0) {
                if (act && valid && ((key & mbits) == prefix)) { const unsigned bin = (key >> shift) & bmask; __hip_atomic_fetch_add(hist + (bin >> 1), 1u << (16 * (bin & 1)), __ATOMIC_RELAXED, __HIP_MEMORY_SCOPE_WORKGROUP); }
            } else {
                const bool tie = valid && key == tau;
                const unsigned long long tb = __ballot(tie);
                bool sel = valid && key > tau;
                if (tb) { const unsigned tb32 = hi ? (unsigned)(tb >> 32) : (unsigned)tb; const unsigned rank = run + __popc(tb32 & L.lower); if (tie && rank < req) sel = true; run += __popc(tb32); }
                const unsigned long long sb = __ballot(sel);
                const unsigned q0 = (unsigned)sb, q1 = (unsigned)(sb >> 32);
                if ((j & 1) == 0) { wq0h0 = q0 & 0xffffu; wq0h1 = q0 >> 16; wq1h0 = q1 & 0xffffu; wq1h1 = q1 >> 16; }
                else { wq0h0 |= q0 << 16; wq0h1 |= q0 & 0xffff0000u; wq1h0 |= q1 << 16; wq1h1 |= q1 & 0xffff0000u;
                    if (lane < 4) { const unsigned v = lane == 0 ? wq0h0 : (lane == 1 ? wq0h1 : (lane == 2 ? wq1h0 : wq1h1));
                        maskout[((size_t)(t0 + (lane >> 1)) * 128 + (i * 2 + (j >> 1))) * 2 + (lane & 1)] = v; } }
            }
        }
        if (more) { LAS unsigned char* nb = lds + ((i + 1) & 1) * KT_BYTES; *(LAS v4u*)(nb + w0) = s0; *(LAS v4u*)(nb + w1) = s1; }
        __syncthreads();
    }
}
__device__ __forceinline__ void topk_block(int b, const bf16* proj, unsigned* maskout, LAS unsigned char* lds, int tid, int lane, int wave) {
    const int lam = lane & 31, hi = lane >> 5;
    Lane L;
    L.kperm = crow(lam & 15, lam >> 4);
    const int t0 = 16 * b + 2 * wave; L.tq = t0 + hi;
    { const int qsel = (lam >> 2) & 1, head = (lam & 3) + 4 * (lam >> 3);
      const bf16* qp = proj + (size_t)(t0 + qsel) * NPROJ + C_IQ + head * 64 + 8 * hi;
#pragma unroll
      for (int ks = 0; ks < 4; ++ks) L.af[ks] = *(const bf16x8*)(qp + 16 * ks); }
    { const v4u a = *(const v4u*)(proj + (size_t)L.tq * NPROJ + C_IW), bq = *(const v4u*)(proj + (size_t)L.tq * NPROJ + C_IW + 8);
      const unsigned wd[8] = {a.x, a.y, a.z, a.w, bq.x, bq.y, bq.z, bq.w};
#pragma unroll
      for (int r = 0; r < 8; ++r) { L.wv[2 * r] = __uint_as_float(wd[r] << 16) * 0.03125f; L.wv[2 * r + 1] = __uint_as_float(wd[r] & 0xffff0000u) * 0.03125f; } }
    { const int sw = (L.kperm >> 1) & 7;
#pragma unroll
      for (int ks = 0; ks < 4; ++ks) L.koff[ks] = (unsigned)(L.kperm * 128 + 16 * ((2 * ks + hi) ^ sw)); }
    { unsigned lw = 0; for (int l2 = 0; l2 < 32; ++l2) if (crow(l2 & 15, l2 >> 4) < L.kperm) lw |= 1u << l2; L.lower = lw; }
    const int tmax = 16 * b + 15; const int nt = tmax / KT + 1; const int ntm = ((b >> 4) + 1) * 2;
    unsigned tau = 0u, req = 0xffffffffu;
    if (tmax >= TOPK) {
        LAS unsigned* hist = (LAS unsigned*)(lds + HIST_OFF + (wave * 2 + hi) * HIST_Q_BYTES);
        unsigned prefix = 0u, mbits = 0u, r = TOPK; bool done = false;
        for (int round = 0; round < 3; ++round) {
            const int shift = round == 0 ? 21 : (round == 1 ? 10 : 0); const unsigned bmask = round == 2 ? 1023u : 2047u;
            { LAS v4u* hz = (LAS v4u*)(lds + HIST_OFF + wave * 2 * HIST_Q_BYTES);
#pragma unroll
              for (int k = 0; k < 8; ++k) hz[lane + 64 * k] = (v4u){0u, 0u, 0u, 0u}; }
            pass<0>(L, proj, maskout, lds, nt, tid, lane, wave, prefix, mbits, shift, bmask, !done, 0u, 0u, t0);
            unsigned cw[32]; unsigned sum = 0;
#pragma unroll
            for (int k = 0; k < 8; ++k) { const v4u v = *(const LAS v4u*)((LAS unsigned char*)hist + lam * 128 + 16 * k); cw[4 * k] = v.x; cw[4 * k + 1] = v.y; cw[4 * k + 2] = v.z; cw[4 * k + 3] = v.w; }
#pragma unroll
            for (int k = 0; k < 32; ++k) sum += (cw[k] & 0xffffu) + (cw[k] >> 16);
            unsigned suf = sum;
#pragma unroll
            for (int o = 1; o < 32; o <<= 1) { const unsigned tt = __shfl_down(suf, o, 32); if (lam + o < 32) suf += tt; }
            unsigned cum = suf - sum;
            const bool mine = !done && cum < r && r <= suf;
            unsigned fb = 0, fr = 0, fc = 0;
            if (mine) {
#pragma unroll
                for (int k = 31; k >= 0; --k) {
                    const unsigned chi = cw[k] >> 16, clo = cw[k] & 0xffffu;
                    if (fc == 0 && cum + chi >= r) { fb = 64 * lam + 2 * k + 1; fr = r - cum; fc = chi; } if (fc == 0) cum += chi;
                    if (fc == 0 && cum + clo >= r) { fb = 64 * lam + 2 * k; fr = r - cum; fc = clo; } if (fc == 0) cum += clo;
                }
            }
            const unsigned long long mb = __ballot(mine);
            const unsigned mb32 = hi ? (unsigned)(mb >> 32) : (unsigned)mb;
            if (mb32) { const int src = (hi << 5) + (__ffs(mb32) - 1);
                fb = __shfl(fb, src); fr = __shfl(fr, src); fc = __shfl(fc, src);
                prefix |= fb << shift; r = fr; if (fc == fr) done = true; }
            mbits |= bmask << shift;
            { volatile LAS unsigned* flag = (volatile LAS unsigned*)(lds + FLAG_OFF);
              if (__ballot(!done) != 0ull && lane == 0) *flag = 1u;
              __syncthreads();
              const unsigned any = *flag;
              __syncthreads();
              if (tid == 0) *flag = 0u;
              if (!any) break; }
        }
        tau = prefix; req = done ? 0xffffffffu : r;
    }
    pass<1>(L, proj, maskout, lds, ntm, tid, lane, wave, 0u, 0u, 0, 0u, false, tau, req, t0);
}
}
__device__ __forceinline__ void mask_to_list_wave(int t, const unsigned* mask, int* sel_idx, int* sel_cnt, int lane, unsigned* dbg_over = nullptr) {
    unsigned long long nat[2]; unsigned cnt[2];
#pragma unroll
    for (int i = 0; i < 2; ++i) { const int T = lane + 64 * i; unsigned long long m = 0ull;
        if (64 * T <= t) { const unsigned w0 = mask[((size_t)t * 128 + T) * 2], w1 = mask[((size_t)t * 128 + T) * 2 + 1];
            for (int bit = 0; bit < 32; ++bit) { const int j = bit >> 4, r = bit & 15;
                if ((w0 >> bit) & 1u) m |= 1ull << (32 * j + tk::crow(r, 0));
                if ((w1 >> bit) & 1u) m |= 1ull << (32 * j + tk::crow(r, 1)); } }
        nat[i] = m; cnt[i] = (unsigned)__popcll(m); }
    unsigned inc0 = cnt[0], inc1 = cnt[1];
#pragma unroll
    for (int o = 1; o < 64; o <<= 1) { const unsigned a = __shfl_up(inc0, o), b = __shfl_up(inc1, o); if (lane >= o) { inc0 += a; inc1 += b; } }
    const unsigned tot0 = __shfl(inc0, 63), tot1 = __shfl(inc1, 63);
    unsigned pos0 = inc0 - cnt[0], pos1 = tot0 + inc1 - cnt[1];
    for (int k = 0; k < 64; ++k) { if ((nat[0] >> k) & 1ull) { if (pos0 < TOPK) sel_idx[(size_t)t * TOPK + pos0] = 64 * lane + k; ++pos0; } }
    for (int k = 0; k < 64; ++k) { if ((nat[1] >> k) & 1ull) { if (pos1 < TOPK) sel_idx[(size_t)t * TOPK + pos1] = 64 * (lane + 64) + k; ++pos1; } }
    if (lane == 0) sel_cnt[t] = (int)((tot0 + tot1) < (unsigned)TOPK ? (tot0 + tot1) : (unsigned)TOPK);
    if (lane == 0 && dbg_over && tot0 + tot1 > (unsigned)TOPK) atomicAdd(dbg_over, 1u);
}
__device__ __forceinline__ void list_compare_wave(int t, const int* ia, const int* ca, const int* ib, const int* cb, unsigned* counter, int lane) {
    const int na = ca[t], nb = cb[t]; bool bad = na != nb;
    for (int i = lane; i < TOPK; i += 64) if (i < na && i < nb && ia[(size_t)t * TOPK + i] != ib[(size_t)t * TOPK + i]) bad = true;
    if (__ballot(bad) && lane == 0) atomicAdd(counter, 1u);
}
namespace at {
constexpr int NW = 8, QBLK = 32, KVBLK = 64, QB = NW * QBLK, D = 128;
constexpr int SHM_V = KVBLK * D * 2, SHM_K = KVBLK * D * 2;
constexpr int LDS_BYTES = 2 * SHM_V + 2 * SHM_K + NW * 64 * 4;
constexpr float SCALE = 0.08838834764831845f, THR = 8.f;
typedef short bf16x8 __attribute__((ext_vector_type(8)));
typedef short s16x4 __attribute__((ext_vector_type(4)));
typedef float f32x16 __attribute__((ext_vector_type(16)));
typedef unsigned u32x4 __attribute__((ext_vector_type(4)));
#define KSWZ(row, colB) ((row) * 256 + ((colB) ^ (((row) & 7) << 4)))
#define SBAR() __builtin_amdgcn_sched_barrier(0)
__device__ __forceinline__ int v_st(int k, int c) { const int kk = (k & ~0xC) | ((k & 4) << 1) | ((k & 8) >> 1); return ((kk >> 3) * 4 + (c >> 5)) * 512 + ((kk & 7) * 32 + (c & 31)) * 2; }
__device__ __forceinline__ int v_rd_base(int lane) { return ((lane & 3) << 3) | (((lane >> 2) & 3) << 6) | (((lane >> 4) & 1) << 5) | (((lane >> 5) & 1) << 8); }
constexpr int v_rd_off(int d0, int ks, int half) { return d0 * 512 + ks * 4096 + half * 2048; }
__device__ __forceinline__ int crow(int r, int hi) { return (r & 3) + 8 * (r >> 2) + 4 * hi; }
__device__ __forceinline__ unsigned cvtpk(float lo, float hi) { unsigned r; asm volatile("v_cvt_pk_bf16_f32 %0, %1, %2" : "=v"(r) : "v"(lo), "v"(hi)); return r; }
__device__ __forceinline__ void mask_tile(f32x16& p0, f32x16& p1, int dq, unsigned W) {
    const float NEG = -__builtin_inff();
#pragma unroll
    for (int r = 0; r < 16; ++r) { const int c = (r & 3) + 8 * (r >> 2);
        if ((unsigned)(dq - c) >= W) p0[r] = NEG;
        if ((unsigned)(dq - c - 32) >= W) p1[r] = NEG; }
}
__device__ __forceinline__ void partialSM(f32x16& p0, f32x16& p1, float& m_reg, float& mn, float& alpha) {
    float pmax = p0[0];
#pragma unroll
    for (int r = 1; r < 16; ++r) pmax = fmaxf(pmax, p0[r]);
#pragma unroll
    for (int r = 0; r < 16; ++r) pmax = fmaxf(pmax, p1[r]);
    { auto rr = __builtin_amdgcn_permlane32_swap(__float_as_uint(pmax), __float_as_uint(pmax), false, false);
      pmax = fmaxf(__uint_as_float(rr[0]), __uint_as_float(rr[1])); }
    constexpr float C2 = 1.4426950408889634f * SCALE;
    if (__builtin_expect(__all((pmax - m_reg) * SCALE <= THR), 1)) { mn = m_reg; alpha = 1.f; }
    else { mn = fmaxf(m_reg, pmax); alpha = __builtin_amdgcn_exp2f((m_reg - mn) * C2); m_reg = mn; }
    const float mnL = -mn * C2;
#pragma unroll
    for (int r = 0; r < 16; ++r) p0[r] = fmaf(p0[r], C2, mnL);
#pragma unroll
    for (int r = 0; r < 16; ++r) p1[r] = fmaf(p1[r], C2, mnL);
#pragma unroll
    for (int r = 0; r < 16; ++r) p0[r] = __builtin_amdgcn_exp2f(p0[r]);
}
__device__ __forceinline__ void finishSM(f32x16& p0, f32x16& p1, float alpha, float& l_reg, bf16x8& pa0, bf16x8& pa1, bf16x8& pa2, bf16x8& pa3) {
#pragma unroll
    for (int r = 0; r < 16; ++r) p1[r] = __builtin_amdgcn_exp2f(p1[r]);
    float ps = 0;
#pragma unroll
    for (int r = 0; r < 16; ++r) ps += p0[r];
#pragma unroll
    for (int r = 0; r < 16; ++r) ps += p1[r];
    { auto rr = __builtin_amdgcn_permlane32_swap(__float_as_uint(ps), __float_as_uint(ps), false, false);
      ps = __uint_as_float(rr[0]) + __uint_as_float(rr[1]); }
    l_reg = l_reg * alpha + ps;
#define PK4(P, B_, OUT) do { unsigned a0 = cvtpk(P[B_+0], P[B_+1]), a1 = cvtpk(P[B_+2], P[B_+3]);                          \
        unsigned b0 = cvtpk(P[B_+4], P[B_+5]), b1 = cvtpk(P[B_+6], P[B_+7]);                                             \
        auto r0 = __builtin_amdgcn_permlane32_swap(a0, b0, false, false); auto r1 = __builtin_amdgcn_permlane32_swap(a1, b1, false, false); \
        u32x4 w = {r0[0], r1[0], r0[1], r1[1]}; OUT = *reinterpret_cast<bf16x8*>(&w); } while (0)
    PK4(p0, 0, pa0); PK4(p0, 8, pa1); PK4(p1, 0, pa2); PK4(p1, 8, pa3);
#undef PK4
}
template <int KB>
__device__ __forceinline__ void qkt(f32x16& p0, f32x16& p1, const f32x16& i0, const f32x16& i1, const char* K_lds, int kbase  , const bf16x8* qr) {
    p0 = i0; p1 = i1;
    asm volatile("" : "+v"(kbase));
    const char* kb[4];
#pragma unroll
    for (int dd = 0; dd < 4; ++dd) kb[dd] = K_lds + KB * SHM_K + (kbase ^ (dd << 5));
#pragma unroll
    for (int d0 = 0; d0 < 8; ++d0) { const char* a = kb[d0 & 3] + (d0 >> 2) * 128;
        bf16x8 b0 = *reinterpret_cast<const bf16x8*>(a);
        bf16x8 b1 = *reinterpret_cast<const bf16x8*>(a + 32 * 256);
        p0 = __builtin_amdgcn_mfma_f32_32x32x16_bf16(b0, qr[d0], p0, 0, 0, 0);
        p1 = __builtin_amdgcn_mfma_f32_32x32x16_bf16(b1, qr[d0], p1, 0, 0, 0); }
}
template <int VB>
__device__ __forceinline__ void pv_tile(f32x16* o, int vb0, bf16x8 pa0, bf16x8 pa1, bf16x8 pa2, bf16x8 pa3) {
#define TRRD(dst, off) asm volatile("ds_read_b64_tr_b16 %0, %1 offset:%2" : "=&v"(dst) : "v"(vb0), "i"(off) : "memory")
#define PV_D0(d0) do { s16x4 l0, l1, l2, l3, h0, h1, h2, h3; constexpr int b_ = VB * SHM_V + v_rd_off(d0, 0, 0); \
        TRRD(l0, b_); TRRD(h0, b_ + 2048); TRRD(l1, b_ + 4096); TRRD(h1, b_ + 6144); TRRD(l2, b_ + 8192); TRRD(h2, b_ + 10240); TRRD(l3, b_ + 12288); TRRD(h3, b_ + 14336); \
        asm volatile("s_waitcnt lgkmcnt(0)" ::: "memory"); SBAR();   \
        o[d0] = __builtin_amdgcn_mfma_f32_32x32x16_bf16(pa0, (bf16x8){l0[0], l0[1], l0[2], l0[3], h0[0], h0[1], h0[2], h0[3]}, o[d0], 0, 0, 0);   \
        o[d0] = __builtin_amdgcn_mfma_f32_32x32x16_bf16(pa1, (bf16x8){l1[0], l1[1], l1[2], l1[3], h1[0], h1[1], h1[2], h1[3]}, o[d0], 0, 0, 0);   \
        o[d0] = __builtin_amdgcn_mfma_f32_32x32x16_bf16(pa2, (bf16x8){l2[0], l2[1], l2[2], l2[3], h2[0], h2[1], h2[2], h2[3]}, o[d0], 0, 0, 0);   \
        o[d0] = __builtin_amdgcn_mfma_f32_32x32x16_bf16(pa3, (bf16x8){l3[0], l3[1], l3[2], l3[3], h3[0], h3[1], h3[2], h3[3]}, o[d0], 0, 0, 0); } while (0)
    PV_D0(0); PV_D0(1); PV_D0(2); PV_D0(3);
#undef PV_D0
#undef TRRD
}
struct Unit {
    const bf16* Q; const bf16* K; const bf16* V; size_t ld; int P0, j_lo, j_hi;
    float slopeR;
    const unsigned* mrow;
};
struct UnitOut { bf16* O; size_t ldo; float* lse; int ldl; };

template <int MODE> __device__ __forceinline__ void make_init(f32x16& i0, f32x16& i1, float slopeR, int kb, int hi, unsigned mw, int dq, unsigned W) {
    const float base = slopeR * (float)(kb + 4 * hi); const float NEG = -__builtin_inff();
#pragma unroll
    for (int r = 0; r < 16; ++r) { const int ci = (r & 3) + 8 * (r >> 2); const float c = (float)ci;
        float b0 = fmaf(slopeR, c, base), b1 = fmaf(slopeR, c + 32.f, base);
        if (MODE == 0) { b0 = ((mw >> r) & 1u) ? b0 : NEG; b1 = ((mw >> (16 + r)) & 1u) ? b1 : NEG; }
        else { if ((unsigned)(dq - ci) >= W) b0 = NEG; if ((unsigned)(dq - ci - 32) >= W) b1 = NEG; }
        i0[r] = b0; i1[r] = b1; }
}
#define VMW() asm volatile("s_waitcnt vmcnt(0)" ::: "memory")
#define SLOAD_H(k0) do { const size_t tb_ = (size_t)(k0) * ldb; const char* kt_ = (const char*)U.K + tb_; const char* vt_ = (const char*)U.V + tb_; \
        st_v0 = *(const bf16x8*)(vt_ + soff0); st_v1 = *(const bf16x8*)(vt_ + soff1); st_k0 = *(const bf16x8*)(kt_ + soff0); st_k1 = *(const bf16x8*)(kt_ + soff1); } while (0)
#define SWRITE_HK(bf) do { *(bf16x8*)(K_lds + (bf) * SHM_K + kws) = st_k0; *(bf16x8*)(K_lds + (bf) * SHM_K + kws + 32 * 256) = st_k1; } while (0)
#define SWRITE_HV(bf) do { *(bf16x8*)(V_lds + (bf) * SHM_V + vst0) = st_v0; *(bf16x8*)(V_lds + (bf) * SHM_V + vst1) = st_v1; } while (0)
#define SWRITE_H(bf) do { SWRITE_HV(bf); SWRITE_HK(bf); } while (0)
template <int MODE  , class OutFn>
__device__ __forceinline__ void attn_unit(const Unit& U, int W, char* lds, const OutFn& outfn) {
    const int tid = threadIdx.x, wid = __builtin_amdgcn_readfirstlane(tid >> 6), lane = tid & 63, r32 = lane & 31, hi = lane >> 5;
    const size_t ldb = U.ld * 2;
    const int NT = U.j_hi - U.j_lo;
    const int qlo = U.P0 + wid * QBLK, qm = qlo + r32 - 4 * hi;
    char* V_lds = lds; char* K_lds = lds + 2 * SHM_V;
    float* ws = (float*)(lds + 2 * SHM_V + 2 * SHM_K) + wid * 64; float* li_l = ws, * al_l = ws + 32;
    float m_reg = -1e30f, l_reg = 0; f32x16 o[4] = {};
    const int sr = tid >> 4, sc = (tid & 15) * 8, vst0 = v_st(sr, sc), vst1 = v_st(32 + sr, sc), kws = KSWZ(sr, sc * 2);
    const unsigned soff0 = (unsigned)(sr * (unsigned)ldb + sc * 2), soff1 = soff0 + 32u * (unsigned)ldb;
    const int vb0 = (int)(uintptr_t)V_lds + v_rd_base(lane);
    const int kbase = KSWZ(r32, hi * 16);
    bf16x8 qr[8]; bf16x8 st_v0, st_v1, st_k0, st_k1;
    const unsigned moff = (unsigned)(((wid * QBLK + r32) * 128) * 2 + hi) * 4u;
#define RESC(a) do { if (__any((a) < 1.f)) { if (hi == 0) al_l[r32] = (a); asm volatile("s_waitcnt lgkmcnt(0)" ::: "memory");              \
                     for (int d_ = 0; d_ < 4; ++d_) for (int r = 0; r < 16; ++r) o[d_][r] *= al_l[crow(r, hi)]; } } while (0)
#define KBASE(t) ((U.j_lo + (t)) * KVBLK)
#define MASKT(P0_, P1_, t) do { } while (0)
#define MWLOAD(t) ((MODE == 0) ? *(const unsigned*)((const char*)U.mrow + (size_t)(U.j_lo + (t)) * 8 + moff) : 0u)
#define QKT(KB, PX0, PX1, t, mw_) do { f32x16 i0_, i1_; int ln_ = lane; asm volatile("" : "+v"(ln_)); make_init<MODE>(i0_, i1_, U.slopeR, KBASE(t), hi, (mw_), qlo + (ln_ & 31) - 4 * (ln_ >> 5) - KBASE(t), (unsigned)W); qkt<KB>(PX0, PX1, i0_, i1_, K_lds, kbase, qr); } while (0)
#pragma unroll
    for (int d0 = 0; d0 < 8; ++d0) qr[d0] = *(const bf16x8*)((const char*)U.Q + (unsigned)((wid * QBLK + r32) * (unsigned)ldb + (d0 * 16 + hi * 8) * 2));
    unsigned mwA = MWLOAD(0), mwB = 0u;
    SLOAD_H(KBASE(0)); VMW(); SWRITE_H(0);
    __syncthreads();
    f32x16 pA0, pA1, pB0, pB1; float mnA, mnB, alA, alB; bf16x8 pa0, pa1, pa2, pa3;
    if (NT > 1) { SLOAD_H(KBASE(1)); mwB = MWLOAD(1); }
    SBAR(); QKT(0, pA0, pA1, 0, mwA);
    MASKT(pA0, pA1, 0); partialSM(pA0, pA1, m_reg, mnA, alA);
    if (NT > 1) { VMW(); SWRITE_H(1); }
    __syncthreads();
#define HALF_STEP(PX0, PX1, mnX, alX, PY0, PY1, alY, t, KB, VB, SB, mwX, mwY) do {                                        \
        SBAR(); QKT(KB, PX0, PX1, t, mwX);                                                                                  \
        finishSM(PY0, PY1, alY, l_reg, pa0, pa1, pa2, pa3); SBAR();                                                           \
        if ((t) + 1 < NT) { SLOAD_H(KBASE((t) + 1)); mwY = MWLOAD((t) + 1); SBAR(); }                                       \
        pv_tile<VB>(o, vb0, pa0, pa1, pa2, pa3); MASKT(PX0, PX1, (t)); partialSM(PX0, PX1, m_reg, mnX, alX);              \
        __syncthreads();                                                                                                      \
        if ((t) + 1 < NT) { VMW(); SWRITE_H(SB); }                                                                            \
        RESC(alX); __syncthreads(); } while (0)
    for (int t = 1; t + 1 < NT; t += 2) {
        HALF_STEP(pB0, pB1, mnB, alB, pA0, pA1, alA, t, 1, 0, 0, mwB, mwA);
        HALF_STEP(pA0, pA1, mnA, alA, pB0, pB1, alB, t + 1, 0, 1, 1, mwA, mwB);
    }
    const bool even = (NT & 1) == 0;
    if (even) { SBAR(); QKT(1, pB0, pB1, NT - 1, mwB); SBAR(); }
    finishSM(pA0, pA1, alA, l_reg, pa0, pa1, pa2, pa3); SBAR();
    pv_tile<0>(o, vb0, pa0, pa1, pa2, pa3);
    if (even) { MASKT(pB0, pB1, NT - 1); partialSM(pB0, pB1, m_reg, mnB, alB); __syncthreads(); RESC(alB);
        finishSM(pB0, pB1, alB, l_reg, pa0, pa1, pa2, pa3); SBAR(); pv_tile<1>(o, vb0, pa0, pa1, pa2, pa3); }
    if (hi == 0) li_l[r32] = l_reg; asm volatile("s_waitcnt lgkmcnt(0)" ::: "memory");
    float rli[16];
#pragma unroll
    for (int r = 0; r < 16; ++r) { const float lv = li_l[crow(r, hi)]; rli[r] = lv > 0.f ? __builtin_amdgcn_rcpf(lv) : 0.f; }
    const UnitOut UO = outfn();
    bf16* Ow = UO.O + (size_t)(wid * QBLK) * UO.ldo;
#pragma unroll
    for (int r = 0; r < 16; ++r) { const int orow = crow(r, hi);
#pragma unroll
        for (int d0 = 0; d0 < 4; ++d0) { const float v = o[d0][r] * rli[r]; const float vn = __shfl_xor(v, 1);
            if ((r32 & 1) == 0) *(unsigned*)(Ow + (size_t)orow * UO.ldo + d0 * 32 + r32) = cvtpk(v, vn); } }
    if (hi == 0) { constexpr float C2 = 1.4426950408889634f * SCALE;
        const float lse2 = l_reg > 0.f ? (m_reg - U.slopeR * (float)(qlo + r32)) * C2 + __builtin_amdgcn_logf(l_reg) : -__builtin_inff();
        UO.lse[(size_t)(wid * QBLK + r32) * UO.ldl] = lse2; }
    __syncthreads();
#undef RESC
#undef KBASE
#undef MASKT
#undef MWLOAD
#undef QKT
#undef HALF_STEP
}
#undef ROW
#undef VMW
#undef SLOAD_H
#undef SWRITE_HK
#undef SWRITE_HV
#undef SWRITE_H
#undef KSWZ
#undef SBAR
}
constexpr int N_ATTN_UNITS = 1024;
struct AttnBufs { const bf16* proj; const unsigned* mask; bf16* opa[4]; float* lsea; bf16* opb; float* lseb; };
__device__ __forceinline__ AttnBufs attn_bufs(unsigned char* ws) { return AttnBufs{(const bf16*)(ws + WS_PROJ), (const unsigned*)(ws + WS_MASK), {(bf16*)(ws + WS_OPA0), (bf16*)(ws + WS_OPA1), (bf16*)(ws + WS_OPA2), (bf16*)(ws + WS_OPA3)}, (float*)(ws + WS_LSEA), (bf16*)(ws + WS_OPB), (float*)(ws + WS_LSEB)}; }
__device__ __forceinline__ int opa_rowoff(int c) { return c == 0 ? 0 : (c == 1 ? 8192 : (c == 2 ? 14336 : 18432)); }
__device__ __forceinline__ size_t opa_base(int c) { return c == 0 ? WS_OPA0 : (c == 1 ? WS_OPA1 : (c == 2 ? WS_OPA2 : WS_OPA3)); }
struct UnitId { int mode, h, qb, c, t0, t1; };
__device__ __forceinline__ UnitId attn_unit_id(int u) {
    UnitId I;
    if (u < 640) { I.mode = 0;
        if (u < 416) { I.h = u / 52; int v = u % 52; int qb = 31, c = 0; for (;; --qb) { const int cnt = (qb + 1) >> 3; if (v < cnt) { c = v; break; } v -= cnt; } I.qb = qb; I.c = c; I.t0 = 32 * c; I.t1 = I.t0 + 32; }
        else { const int w = u - 416, k = 7 - w / 32, e = w % 32; I.h = e >> 2; I.c = e & 3; I.qb = k - 1 + 8 * I.c; I.t0 = 32 * I.c; I.t1 = I.t0 + 4 * k; }
    } else { I.mode = 1; const int w = u - 640; I.h = w >> 5; const int idx = w & 31, g = I.h >> 2, d = 1 << (2 * g), nqb = 32 / d; I.c = idx / nqb  ; I.qb = idx % nqb; I.t0 = 0; I.t1 = 0; }
    return I;
}
__device__ __forceinline__ void attn_decode_in(const UnitId& I, at::Unit& U, unsigned char* ws) {
    const bf16* proj = (const bf16*)(ws + WS_PROJ);
    if (I.mode == 0) {
        U.Q = proj + (size_t)(256 * I.qb) * NPROJ + C_AQ + I.h * 128; U.K = proj + C_AK + I.h * 128; U.V = proj + C_AV + I.h * 128; U.ld = NPROJ; U.P0 = 256 * I.qb; U.j_lo = I.t0; U.j_hi = I.t1;
        U.slopeR = exp2f(-0.4f * (float)(13 + I.h)) * (1.0f / at::SCALE);
        U.mrow = (const unsigned*)(ws + WS_MASK) + (size_t)(256 * I.qb) * 256;
    } else {
        const int g = I.h >> 2, d = 1 << (2 * g), P0 = 256 * I.qb; const size_t tok0 = (size_t)P0 * d + I.c;
        U.Q = proj + tok0 * NPROJ + C_BQ + I.h * 128; U.K = proj + (size_t)I.c * NPROJ + C_BK + I.h * 128; U.V = proj + (size_t)I.c * NPROJ + C_BV + I.h * 128; U.ld = (size_t)d * NPROJ; U.P0 = P0;
        U.j_lo = (P0 >= 128 ? P0 - 128 : 0) / 64; U.j_hi = (P0 + 255) / 64 + 1;
        U.slopeR = exp2f(-0.4f * (float)(I.h + 1)) * (float)d * (1.0f / at::SCALE);
        U.mrow = nullptr;
    }
}
__device__ __forceinline__ at::UnitOut attn_decode_out(const UnitId& I, unsigned char* ws) {
    at::UnitOut O;
    if (I.mode == 0) { const int row = 256 * I.qb - 2048 * I.c;
        O.O = (bf16*)(ws + opa_base(I.c)) + (size_t)row * 1024 + I.h * 128; O.ldo = 1024; O.lse = (float*)(ws + WS_LSEA) + (size_t)(opa_rowoff(I.c) + row) * 8 + I.h; O.ldl = 8;
    } else { const int g = I.h >> 2, j = I.h & 3, d = 1 << (2 * g); const size_t tok0 = (size_t)(256 * I.qb) * d + I.c;
        O.O = (bf16*)(ws + WS_OPB) + (size_t)g * S_ * 512 + tok0 * 512 + j * 128; O.ldo = (size_t)d * 512; O.lse = (float*)(ws + WS_LSEB) + (size_t)g * S_ * 4 + tok0 * 4 + j; O.ldl = 4 * d; }
    return O;
}
__device__ __forceinline__ void attn_run_unit(int u, unsigned char* ws, char* lds) {
    const UnitId I = attn_unit_id(u);
    at::Unit U; attn_decode_in(I, U, ws);
    auto outfn = [u, ws]() { int u2 = u; asm volatile("" : "+s"(u2)); const UnitId I2 = attn_unit_id(u2); return attn_decode_out(I2, ws); };
    if (I.mode == 0) at::attn_unit<0>(U, 0, lds, outfn); else at::attn_unit<1>(U, 129, lds, outfn);
}
__device__ __forceinline__ void combine_token(int t, const AttnBufs& B, bf16* oa, bf16* ob, int lane) {
    { const int h = lane >> 3, e0 = (lane & 7) * 16; const int nc = (t >> 11) + 1;
      float ls[4]; float mx = -INFINITY;
#pragma unroll
      for (int c = 0; c < 4; ++c) { ls[c] = c < nc ? B.lsea[(size_t)(opa_rowoff(c) + t - 2048 * c) * 8 + h] : -INFINITY; mx = fmaxf(mx, ls[c]); }
      float acc[16]; float den = 0.f;
#pragma unroll
      for (int i = 0; i < 16; ++i) acc[i] = 0.f;
#pragma unroll
      for (int c = 0; c < 4; ++c) { if (c < nc) { const float wgt = exp2f(ls[c] - mx); den += wgt;
              const v4u* p = (const v4u*)(B.opa[c] + (size_t)(t - 2048 * c) * 1024 + h * 128 + e0); const v4u a = p[0], b = p[1];
              const unsigned wd[8] = {a.x, a.y, a.z, a.w, b.x, b.y, b.z, b.w};
#pragma unroll
              for (int i = 0; i < 8; ++i) { acc[2 * i] = fmaf(wgt, __uint_as_float(wd[i] << 16), acc[2 * i]); acc[2 * i + 1] = fmaf(wgt, __uint_as_float(wd[i] & 0xffff0000u), acc[2 * i + 1]); } } }
      const float inv = 1.f / den;
      v4u o0, o1; o0.x = pk2(acc[0] * inv, acc[1] * inv); o0.y = pk2(acc[2] * inv, acc[3] * inv); o0.z = pk2(acc[4] * inv, acc[5] * inv); o0.w = pk2(acc[6] * inv, acc[7] * inv);
      o1.x = pk2(acc[8] * inv, acc[9] * inv); o1.y = pk2(acc[10] * inv, acc[11] * inv); o1.z = pk2(acc[12] * inv, acc[13] * inv); o1.w = pk2(acc[14] * inv, acc[15] * inv);
      v4u* q = (v4u*)(oa + (size_t)t * 1024 + h * 128 + e0); q[0] = o0; q[1] = o1; }
    { const int j = lane >> 4, e0 = (lane & 15) * 8;
      float ls[3]; float mx = -INFINITY;
#pragma unroll
      for (int g = 0; g < 3; ++g) { ls[g] = B.lseb[(size_t)g * S_ * 4 + (size_t)t * 4 + j]; mx = fmaxf(mx, ls[g]); }
      float acc[8]; float den = 0.f;
#pragma unroll
      for (int i = 0; i < 8; ++i) acc[i] = 0.f;
#pragma unroll
      for (int g = 0; g < 3; ++g) { const float wgt = exp2f(ls[g] - mx); den += wgt;
          const v4u a = *(const v4u*)(B.opb + (size_t)g * S_ * 512 + (size_t)t * 512 + j * 128 + e0); const unsigned wd[4] = {a.x, a.y, a.z, a.w};
#pragma unroll
          for (int i = 0; i < 4; ++i) { acc[2 * i] = fmaf(wgt, __uint_as_float(wd[i] << 16), acc[2 * i]); acc[2 * i + 1] = fmaf(wgt, __uint_as_float(wd[i] & 0xffff0000u), acc[2 * i + 1]); } }
      const float inv = 1.f / den;
      v4u o; o.x = pk2(acc[0] * inv, acc[1] * inv); o.y = pk2(acc[2] * inv, acc[3] * inv); o.z = pk2(acc[4] * inv, acc[5] * inv); o.w = pk2(acc[6] * inv, acc[7] * inv);
      *(v4u*)(ob + (size_t)t * 512 + j * 128 + e0) = o; }
}
#define XB_TMO      128
#define XB_XCNT(j)  (256  + 64 * (j))
#define XB_XSUB(j)  (1280 + 64 * (j))
#define XB_XGEN(j)  (2304 + 64 * (j))
#define XB_TOP      3328
#define XB_TOPGEN   3392
#define XCD_BAR_WORDS 3456
#define XB_SPIN_CAP (1u << 22)

__device__ __forceinline__ unsigned xb_ld(unsigned* p)              { return __hip_atomic_load(p, __ATOMIC_RELAXED, __HIP_MEMORY_SCOPE_AGENT); }
__device__ __forceinline__ unsigned xb_add(unsigned* p, unsigned v) { return __hip_atomic_fetch_add(p, v, __ATOMIC_RELAXED, __HIP_MEMORY_SCOPE_AGENT); }
__device__ __forceinline__ unsigned xb_xcc_id() { return (unsigned)__builtin_amdgcn_s_getreg((3 << 11) | 20) & 0xFu; }
#define XB_SPIN(cond, bar) do { unsigned _sp = 0; while (cond) { __builtin_amdgcn_s_sleep(1); \
    if ((++_sp & 255u) == 0u) { if (xb_ld(&(bar)[XB_TMO])) break; if (_sp > XB_SPIN_CAP) { atomicAdd(&(bar)[XB_TMO], 1u); break; } } } } while (0)

struct XcdBarrier {
    unsigned* bar; unsigned x;
    volatile LAS unsigned* st;
};

__device__ __forceinline__ XcdBarrier xcd_barrier_post(unsigned* bar, volatile LAS unsigned* st) {
    XcdBarrier b; b.bar = bar; b.x = xb_xcc_id(); b.st = st;
    if (threadIdx.x == 0) (void)xb_add(&bar[XB_XCNT(b.x)], 1u);
    return b;
}
__device__ __forceinline__ void xcd_barrier_complete(unsigned* bar, unsigned x, unsigned& nloc, unsigned& nx) {
    const unsigned G = gridDim.x * gridDim.y * gridDim.z;
    unsigned sum, cnt, mine, sp = 0u;
    for (;;) {
        sum = 0u; cnt = 0u; mine = 0u;
#pragma unroll
        for (unsigned j = 0; j < 16; ++j) { const unsigned c = xb_ld(&bar[XB_XCNT(j)]); sum += c; cnt += (c > 0u) ? 1u : 0u; mine = (j == x) ? c : mine; }
        if (sum == G) break;
        __builtin_amdgcn_s_sleep(1);
        if ((++sp & 255u) == 0u) { if (xb_ld(&bar[XB_TMO])) break; if (sp > XB_SPIN_CAP) { atomicAdd(&bar[XB_TMO], 1u); break; } }
    }
    nloc = mine > 0u ? mine : 1u; nx = cnt > 0u ? cnt : 1u;
}

__device__ __forceinline__ void xcd_barrier(const XcdBarrier& b) {
    asm volatile("s_waitcnt vmcnt(0)" ::: "memory");
    __syncthreads();
    if (threadIdx.x == 0) {
        unsigned* bar = b.bar;
        __builtin_amdgcn_s_waitcnt(0);
        unsigned nloc = b.st[0], nx = b.st[1];
        if (nloc == 0u) { xcd_barrier_complete(bar, b.x, nloc, nx); b.st[0] = nloc; b.st[1] = nx; }
        const unsigned old = xb_add(&bar[XB_XSUB(b.x)], 1u);
        const unsigned gen = old / nloc;
        if (old + 1u == (gen + 1u) * nloc) {
            __builtin_amdgcn_fence(__ATOMIC_RELEASE, "agent");
            asm volatile("s_waitcnt vmcnt(0)" ::: "memory");
            const unsigned og = xb_add(&bar[XB_TOP], 1u);
            const unsigned tg = og / nx;
            if (og + 1u == (tg + 1u) * nx) xb_add(&bar[XB_TOPGEN], 1u);
            else XB_SPIN(xb_ld(&bar[XB_TOPGEN]) == tg, bar);
            __builtin_amdgcn_fence(__ATOMIC_ACQUIRE, "agent");
            xb_add(&bar[XB_XGEN(b.x)], 1u);
            asm volatile("s_waitcnt vmcnt(0)" ::: "memory");
        } else {
            XB_SPIN(xb_ld(&bar[XB_XGEN(b.x)]) == gen, bar);
            __builtin_amdgcn_fence(__ATOMIC_ACQUIRE, "agent");
            asm volatile("s_waitcnt vmcnt(0)" ::: "memory");
        }
    }
    __syncthreads();
}

enum { P_PRO = 0, P_PROJ, P_TOPK, P_ATTN, P_COMB, P_MERGE, P_WOUT, P_LN1, P_GU, P_DOWN, P_LN2, NPH };
struct Args { const float* in[12]; float* out; unsigned char* ws; int ph_lo, ph_hi, li, pad; };
__global__ void __launch_bounds__(NWAVES * 64, 2) mega_kernel(Args args) {
    extern __shared__ __attribute__((aligned(16))) unsigned char lds_raw[];
    LAS unsigned char* lds = (LAS unsigned char*)lds_raw;
    volatile LAS unsigned* MISC = (volatile LAS unsigned*)(lds + MISC_OFF);
    const int tid = threadIdx.x, lane = tid & 63, wave = __builtin_amdgcn_readfirstlane(tid >> 6);
    const int G = gridDim.x, bx = blockIdx.x; const int vcu = (G % 8 == 0) ? (bx % 8) * (G / 8) + bx / 8 : bx;
    unsigned char* ws = args.ws; unsigned* ctl = (unsigned*)(ws + WS_CTL);
    for (int u = tid; u < (LDS_BYTES - LDSCTL_OFF) / 4; u += NWAVES * 64) ((LAS unsigned*)(lds + LDSCTL_OFF))[u] = 0u;
    __syncthreads();
    XcdBarrier bar = xcd_barrier_post(ctl + CW_BAR + args.li * XCD_BAR_WORDS, MISC + 8);
    const int lo = args.ph_lo, hi = args.ph_hi;
#define IN(k) (lo <= (k) && (k) < hi)
#define SEAM(k) do { if (IN(k) && IN((k) + 1)) xcd_barrier(bar); } while (0)
    using pg8::bf16_t;
    const float* x = args.in[0]; float* out = args.out;
    const bf16* proj = (const bf16*)(ws + WS_PROJ);

    if (IN(P_PRO)) {
        ProArgs pa{x, args.in[1], args.in[2], args.in[3], args.in[4], args.in[7], args.in[8], args.in[9], ws};
        prologue_body(pa, (float*)(lds_raw + wave * 16384), vcu * NWAVES + wave, G * NWAVES, lane);
    }
    SEAM(P_PRO);
    if (IN(P_PROJ)) {
        pg8::Gemm g{(const bf16_t*)(ws + WS_XB), (const bf16_t*)(ws + WS_WT_IN), S_, NPROJ, DM}; pg8::StaticOrder S; S.init(S_, NPROJ, G, bx);
        pg8::EpiProj E{(bf16_t*)(ws + WS_PROJ), NPROJ, C_GA, C_IK};
        pg8::gemm_phase<pg8::EpiProj, pg8::StaticOrder, PG8_ALIGN, PG8_SP2>(lds, g, S, E);
    }
    SEAM(P_PROJ);
    if (IN(P_TOPK)) {
#if DBG_TOPK
        for (int t = S_ - 1 - bx; t >= 0; t -= G) naive_topk_query<NWAVES * 64>(t, proj, (int*)(ws + WS_SELIDX2), (int*)(ws + WS_SELCNT2), (float*)lds_raw);
        __syncthreads();
#endif
        for (int i = bx; i < S_ / 32; i += G) { tk::topk_block(S_ / 16 - 1 - i, proj, (unsigned*)(ws + WS_MASK), lds, tid, lane, wave); tk::topk_block(i, proj, (unsigned*)(ws + WS_MASK), lds, tid, lane, wave); }
#if NAIVE_ATTN || DBG_ATTN || DBG_TOPK
        xcd_barrier(bar);
        for (int t = vcu * NWAVES + wave; t < S_; t += G * NWAVES) mask_to_list_wave(t, (const unsigned*)(ws + WS_MASK), (int*)(ws + WS_SELIDX), (int*)(ws + WS_SELCNT), lane);
#endif
#if DBG_TOPK
        for (int t = vcu * NWAVES + wave; t < S_; t += G * NWAVES) list_compare_wave(t, (const int*)(ws + WS_SELIDX), (const int*)(ws + WS_SELCNT), (const int*)(ws + WS_SELIDX2), (const int*)(ws + WS_SELCNT2), ctl + 16, lane);
#endif
    }
    SEAM(P_TOPK);
    if (IN(P_ATTN)) {
#if NAIVE_ATTN
        for (int t = S_ - 1 - bx; t >= 0; t -= G) naive_attn_a_wave(t, wave, proj, (const int*)(ws + WS_SELIDX), (const int*)(ws + WS_SELCNT), (bf16*)(ws + WS_OA), (float*)(lds_raw + wave * 4096), lane);
        for (int tp = bx; tp < S_ / 2; tp += G) naive_attn_b_wave(2 * tp + (wave >> 2), wave & 3, proj, (bf16*)(ws + WS_OB), (float*)(lds_raw + wave * 4096), lane);
#else
        for (;;) {
            if (tid == 0) MISC[17] = atomicAdd(ctl + 32, 1u);
            __syncthreads();
            const int u = __builtin_amdgcn_readfirstlane((int)MISC[17]);
            if (u >= N_ATTN_UNITS) break;
            attn_run_unit(u, ws, (char*)lds_raw);
        }
#endif
    }
    SEAM(P_ATTN);
    if (IN(P_COMB)) {
#if !NAIVE_ATTN
        for (int t = vcu * NWAVES + wave; t < S_; t += G * NWAVES) combine_token(t, attn_bufs(ws), (bf16*)(ws + WS_OA), (bf16*)(ws + WS_OB), lane);
#if DBG_ATTN
        xcd_barrier(bar);
        for (int t = S_ - 1 - bx; t >= 0; t -= G) naive_attn_a_wave(t, wave, proj, (const int*)(ws + WS_SELIDX), (const int*)(ws + WS_SELCNT), (bf16*)(ws + WS_OA), (float*)(lds_raw + wave * 4096), lane, ctl + 17);
        for (int tp = bx; tp < S_ / 2; tp += G) naive_attn_b_wave(2 * tp + (wave >> 2), wave & 3, proj, (bf16*)(ws + WS_OB), (float*)(lds_raw + wave * 4096), lane, ctl + 18);
#endif
#endif
    }
    SEAM(P_COMB);
    if (IN(P_MERGE)) {
        { pg8::Gemm g{(const bf16_t*)(ws + WS_OA), (const bf16_t*)(ws + WS_WT_A), S_, DM, 1024}; pg8::StaticOrder S; S.init(S_, DM, G, bx);
          pg8::EpiMerge<1> E{(const bf16_t*)(ws + WS_PROJ), NPROJ, C_GA, out, DM, nullptr, 0};
          pg8::gemm_phase<pg8::EpiMerge<1>, pg8::StaticOrder, PG8_ALIGN, PG8_SP2>(lds, g, S, E); }
        { pg8::Gemm g{(const bf16_t*)(ws + WS_OB), (const bf16_t*)(ws + WS_WT_B), S_, DM, 512}; pg8::StaticOrder S; S.init(S_, DM, G, bx);
          pg8::EpiMerge<2> E{(const bf16_t*)(ws + WS_PROJ), NPROJ, C_GB, out, DM, (bf16_t*)(ws + WS_MERGED), DM};
          pg8::gemm_phase<pg8::EpiMerge<2>, pg8::StaticOrder, PG8_ALIGN, PG8_SP2>(lds, g, S, E); }
    }
    SEAM(P_MERGE);
    if (IN(P_WOUT)) {
        pg8::Gemm g{(const bf16_t*)(ws + WS_MERGED), (const bf16_t*)(ws + WS_WT_OUT), S_, DM, DM}; pg8::StaticOrder S; S.init(S_, DM, G, bx);
        pg8::EpiRes E{x, (float*)(ws + WS_H), DM, ALPHA};
        pg8::gemm_phase<pg8::EpiRes, pg8::StaticOrder, PG8_ALIGN, PG8_SP2>(lds, g, S, E);
    }
    SEAM(P_WOUT);
    if (IN(P_LN1)) { for (int row = vcu * NWAVES + wave; row < S_; row += G * NWAVES) ln_row((const float*)(ws + WS_H), args.in[5], args.in[6], (float*)(ws + WS_H), (bf16*)(ws + WS_HB), row, lane); }
    SEAM(P_LN1);
    if (IN(P_GU)) {
        pg8::Gemm g{(const bf16_t*)(ws + WS_HB), (const bf16_t*)(ws + WS_WT_GU), S_, NGU, DM}; pg8::StaticOrder S; S.init(S_, NGU, G, bx);
        pg8::EpiSwiGLU E{(bf16_t*)(ws + WS_ACT), DFF};
        pg8::gemm_phase<pg8::EpiSwiGLU, pg8::StaticOrder, PG8_ALIGN, PG8_SP2>(lds, g, S, E);
    }
    SEAM(P_GU);
    if (IN(P_DOWN)) {
        pg8::Gemm g{(const bf16_t*)(ws + WS_ACT), (const bf16_t*)(ws + WS_WT_DOWN), S_, DM, DFF}; pg8::StaticOrder S; S.init(S_, DM, G, bx);
        pg8::EpiRes E{(const float*)(ws + WS_H), out, DM, ALPHA};
        pg8::gemm_phase<pg8::EpiRes, pg8::StaticOrder, PG8_ALIGN, PG8_SP2>(lds, g, S, E);
    }
    SEAM(P_DOWN);
    if (IN(P_LN2)) { for (int row = vcu * NWAVES + wave; row < S_; row += G * NWAVES) ln_row(out, args.in[10], args.in[11], out, (bf16*)nullptr, row, lane); }
#if DBG_ANY
    if (IN(P_LN2) && vcu == 0 && tid == 0) {
        asm volatile("s_waitcnt vmcnt(0)" ::: "memory");
        const float cntf = (float)__hip_atomic_load(ctl + 16, __ATOMIC_RELAXED, __HIP_MEMORY_SCOPE_AGENT); const float mx = fmaxf(__uint_as_float(__hip_atomic_load(ctl + 17, __ATOMIC_RELAXED, __HIP_MEMORY_SCOPE_AGENT)), DBG_BSEL * __uint_as_float(__hip_atomic_load(ctl + 18, __ATOMIC_RELAXED, __HIP_MEMORY_SCOPE_AGENT)));
        out[0] += 4096.f * sqrtf(cntf + mx);
    }
#endif
#undef IN
#undef SEAM
}

#ifndef MK_CUTS
#define MK_CUTS {0, NPH}
#endif
extern "C" void kernel_launch(void* const* d_in, const int* in_sizes, int n_in, void* d_out, int out_size, void* d_ws, size_t ws_size, hipStream_t stream) {
    static int grid = 0;
    if (grid == 0) {
        if (n_in != 12 || in_sizes[0] != S_ * DM || out_size != S_ * DM || ws_size < WS_END) { fprintf(stderr, "kernel_launch: unexpected shapes / workspace (n_in %d, in0 %d, out %d, ws %zu)\n", n_in, n_in > 0 ? in_sizes[0] : -1, out_size, ws_size); grid = -1; return; }
        int dev = 0, cus = 0, per_cu = 0;
        if (hipGetDevice(&dev) != hipSuccess || hipDeviceGetAttribute(&cus, hipDeviceAttributeMultiprocessorCount, dev) != hipSuccess) { grid = -1; return; }
        if (hipFuncSetAttribute((const void*)mega_kernel, hipFuncAttributeMaxDynamicSharedMemorySize, LDS_BYTES) != hipSuccess) { fprintf(stderr, "kernel_launch: hipFuncSetAttribute failed\n"); grid = -1; return; }
        if (hipOccupancyMaxActiveBlocksPerMultiprocessor(&per_cu, (const void*)mega_kernel, NWAVES * 64, LDS_BYTES) != hipSuccess || per_cu < 1) { fprintf(stderr, "kernel_launch: occupancy query says %d workgroups per CU\n", per_cu); (void)hipGetLastError(); grid = -1; return; }
        grid = cus;
    }
    if (grid < 0) return;
    if (hipMemsetAsync((char*)d_ws + WS_CTL, 0, CTL_ZERO_BYTES, stream) != hipSuccess) return;
    Args a{};
    for (int i = 0; i < 12; ++i) a.in[i] = (const float*)d_in[i];
    a.out = (float*)d_out; a.ws = (unsigned char*)d_ws;
    const int cuts[] = MK_CUTS; const int nl = (int)(sizeof(cuts) / sizeof(int)) - 1;
    for (int li = 0; li < nl; ++li) { a.ph_lo = cuts[li]; a.ph_hi = cuts[li + 1]; a.li = li;
        hipLaunchKernelGGL(mega_kernel, dim3(grid), dim3(NWAVES * 64), LDS_BYTES, stream, a); }
}
```

```cpp
#include <hip/hip_runtime.h>
#include <cstdio>
#include <cstdint>
#ifndef DBG_TOPK
#define DBG_TOPK 0
#endif
#ifndef DBG_ATTN
#define DBG_ATTN 0
#endif
#ifndef NAIVE_ATTN
#define NAIVE_ATTN 0
#endif
#ifndef DBG_BSEL
#define DBG_BSEL 1.0f
#endif
#ifndef DBG_TIME
#define DBG_TIME 0
#endif
#ifndef DBG_COUNT
#define DBG_COUNT 0
#endif
#define DBG_ANY (DBG_TOPK || DBG_ATTN || DBG_TIME || DBG_COUNT)
#if DBG_TIME
#define TSTART(id) unsigned long long _t0_##id = 0; if (DBG_TIME == (id)) _t0_##id = __builtin_amdgcn_s_memrealtime()
#define TSTOP(id, acc) do { if (DBG_TIME == (id)) (acc) += (unsigned)(__builtin_amdgcn_s_memrealtime() - _t0_##id); } while (0)
#else
#define TSTART(id)
#define TSTOP(id, acc) do { } while (0)
#endif

namespace pg8 {
#define PG8_LAS __attribute__((address_space(3)))
typedef unsigned short bf16_t;
typedef short bf16x8 __attribute__((ext_vector_type(8)));
typedef float f32x4 __attribute__((ext_vector_type(4)));
typedef unsigned u32x4 __attribute__((ext_vector_type(4)));
constexpr int BM = 256, BK = 64, HALF = 128, HTB = HALF * BK * 2  , STAGE_BYTES = 8 * HTB, NXCD = 8, WGM = 8;

__host__ __device__ __forceinline__ int lds_byte(int r, int c) { const int st = (r >> 4) * 2 + (c >> 5), rr = r & 15, cc = c & 31, ob = rr * 64 + cc * 2; return st * 1024 + (ob ^ (((ob >> 9) & 1) << 5)); }
__host__ __device__ __forceinline__ void stage_rc(int b, int& R, int& C) { const int st = b / 1024, sb = b % 1024, swz = sb ^ (((sb >> 9) & 1) << 5); R = (st >> 1) * 16 + swz / 64; C = (st & 1) * 32 + (swz % 64) / 2; }
__host__ __device__ __forceinline__ int perm32(int rho) { const int n = rho >> 4, i = rho & 15; return 8 * (i >> 2) + 4 * n + (i & 3); }

struct Unit { int pm, pn; };
struct Gemm { const bf16_t* A; const bf16_t* Bt; int M, N, K; };

struct StaticOrder {
    int nM, nN, nwg, G, c;
    __host__ __device__ void init(int M, int N, int G_, int c_) { nM = M / BM; nN = N / BM; nwg = nM * nN; G = G_; c = c_; }
    __host__ __device__ bool next(int i, Unit& u) const {
        const long L = (long)i * G + c; if (L >= nwg) return false;
        int wgid = (int)L; { const int q = nwg / NXCD, r = nwg % NXCD, xcd = wgid % NXCD, off = wgid / NXCD; wgid = (xcd < r ? xcd * (q + 1) : r * (q + 1) + (xcd - r) * q) + off; }
        const int nig = WGM * nN, gid = wgid / nig, fm = gid * WGM, gsz = (nM - fm) < WGM ? (nM - fm) : WGM;
        u.pm = fm + ((wgid % nig) % gsz); u.pn = (wgid % nig) / gsz; return true;
    }
    __device__ __forceinline__ void a_ready(const Unit&) const {}
    __device__ __forceinline__ void done(const Unit&) const {}
};

__device__ __forceinline__ unsigned cvt_pk_bf16(float lo, float hi) { unsigned r; asm volatile("v_cvt_pk_bf16_f32 %0, %1, %2" : "=v"(r) : "v"(lo), "v"(hi)); return r; }
__device__ __forceinline__ float bf_lo(unsigned w) { return __uint_as_float(w << 16); }
__device__ __forceinline__ float bf_hi(unsigned w) { return __uint_as_float(w & 0xffff0000u); }
__device__ __forceinline__ float sigmoidf_fast(float v) { return __builtin_amdgcn_rcpf(1.0f + __builtin_amdgcn_exp2f(-1.4426950408889634f * v)); }

struct EpiProj {
    static constexpr bool PERM = true, AFTER_DRAIN = false;
    bf16_t* O; int ldc; int sig_lo, sig_hi;
    __device__ __forceinline__ void operator()(const f32x4 (&acc)[2][2][4][2], const Unit& u, int wr, int wc, int fr, int fq) const {
        const int row0 = u.pm * BM + wr * 64 + fr; const int colt = u.pn * BM; const bool sg = colt >= sig_lo && colt < sig_hi;
        const int col0 = colt + wc * 32 + 8 * fq;
#pragma unroll
        for (int ai = 0; ai < 2; ++ai)
#pragma unroll
            for (int m = 0; m < 4; ++m) { bf16_t* rowp = O + (size_t)(row0 + ai * HALF + m * 16) * ldc + col0;
#pragma unroll
                for (int bj = 0; bj < 2; ++bj) { f32x4 v0 = acc[ai][bj][m][0], v1 = acc[ai][bj][m][1];
                    if (sg) {
#pragma unroll
                        for (int e = 0; e < 4; ++e) { v0[e] = sigmoidf_fast(v0[e]); v1[e] = sigmoidf_fast(v1[e]); } }
                    u32x4 w; w.x = cvt_pk_bf16(v0[0], v0[1]); w.y = cvt_pk_bf16(v0[2], v0[3]); w.z = cvt_pk_bf16(v1[0], v1[1]); w.w = cvt_pk_bf16(v1[2], v1[3]);
                    *(u32x4*)(rowp + bj * HALF) = w; } }
    }
};
template <int PART> struct EpiMerge {
    static constexpr bool PERM = true, AFTER_DRAIN = false;
    const bf16_t* G; int ldg; int gcol; float* T; int ldt; bf16_t* O; int ldo;
    __device__ __forceinline__ void operator()(const f32x4 (&acc)[2][2][4][2], const Unit& u, int wr, int wc, int fr, int fq) const {
        const int row0 = u.pm * BM + wr * 64 + fr; const int col0 = u.pn * BM + wc * 32 + 8 * fq;
#pragma unroll
        for (int ai = 0; ai < 2; ++ai)
#pragma unroll
            for (int m = 0; m < 4; ++m) { const size_t row = (size_t)(row0 + ai * HALF + m * 16);
#pragma unroll
                for (int bj = 0; bj < 2; ++bj) { const int col = col0 + bj * HALF;
                    const u32x4 gw = *(const u32x4*)(G + row * ldg + gcol + col);
                    f32x4 g0 = {bf_lo(gw.x), bf_hi(gw.x), bf_lo(gw.y), bf_hi(gw.y)}, g1 = {bf_lo(gw.z), bf_hi(gw.z), bf_lo(gw.w), bf_hi(gw.w)};
                    f32x4 v0 = acc[ai][bj][m][0] * g0, v1 = acc[ai][bj][m][1] * g1;
                    float* tp = T + row * ldt + col;
                    if (PART == 1) { *(f32x4*)tp = v0; *(f32x4*)(tp + 4) = v1; }
                    else { v0 = v0 + *(const f32x4*)tp; v1 = v1 + *(const f32x4*)(tp + 4);
                        u32x4 w; w.x = cvt_pk_bf16(v0[0], v0[1]); w.y = cvt_pk_bf16(v0[2], v0[3]); w.z = cvt_pk_bf16(v1[0], v1[1]); w.w = cvt_pk_bf16(v1[2], v1[3]);
                        *(u32x4*)(O + row * ldo + col) = w; } } }
    }
};
struct EpiRes {
    static constexpr bool PERM = false, AFTER_DRAIN = false;
    const float* R; float* Y; int ldc; float alpha;
    __device__ __forceinline__ void operator()(const f32x4 (&acc)[2][2][4][2], const Unit& u, int wr, int wc, int fr, int fq) const {
        const int row0 = u.pm * BM + wr * 64 + fr, col0 = u.pn * BM + wc * 32 + 4 * fq;
#pragma unroll
        for (int ai = 0; ai < 2; ++ai)
#pragma unroll
            for (int m = 0; m < 4; ++m) { const size_t off = (size_t)(row0 + ai * HALF + m * 16) * ldc + col0;
#pragma unroll
                for (int bj = 0; bj < 2; ++bj)
#pragma unroll
                    for (int n = 0; n < 2; ++n) { const f32x4 r = *(const f32x4*)(R + off + bj * HALF + n * 16); *(f32x4*)(Y + off + bj * HALF + n * 16) = r * alpha + acc[ai][bj][m][n]; } }
    }
};
struct EpiSwiGLU {
    static constexpr bool PERM = true, AFTER_DRAIN = false;
    bf16_t* O; int ldc;
    __device__ __forceinline__ void operator()(const f32x4 (&acc)[2][2][4][2], const Unit& u, int wr, int wc, int fr, int fq) const {
        const int row0 = u.pm * BM + wr * 64 + fr; const int col0 = u.pn * HALF + wc * 32 + 8 * fq;
#pragma unroll
        for (int ai = 0; ai < 2; ++ai)
#pragma unroll
            for (int m = 0; m < 4; ++m) { f32x4 g0 = acc[ai][0][m][0], g1 = acc[ai][0][m][1]; const f32x4 u0 = acc[ai][1][m][0], u1 = acc[ai][1][m][1];
#pragma unroll
                for (int e = 0; e < 4; ++e) { g0[e] = g0[e] * sigmoidf_fast(g0[e]) * u0[e]; g1[e] = g1[e] * sigmoidf_fast(g1[e]) * u1[e]; }
                u32x4 w; w.x = cvt_pk_bf16(g0[0], g0[1]); w.y = cvt_pk_bf16(g0[2], g0[3]); w.z = cvt_pk_bf16(g1[0], g1[1]); w.w = cvt_pk_bf16(g1[2], g1[3]);
                *(u32x4*)(O + (size_t)(row0 + ai * HALF + m * 16) * ldc + col0) = w; }
    }
};

template <class Epi, class Sched, bool ALIGN_EPI = false, bool SP2 = false>
__device__ __forceinline__ void gemm_phase(PG8_LAS unsigned char* lds, const Gemm g, const Sched& S, const Epi& E) {
    const int tid = threadIdx.x, wid = __builtin_amdgcn_readfirstlane(tid >> 6), lane = tid & 63, wr = wid >> 2, wc = wid & 3, fr = lane & 15, fq = lane >> 4;
    const int K = g.K, nt = K / BK;
    unsigned voffA[2], voffB[2];
#pragma unroll
    for (int i = 0; i < 2; ++i) { int R, C; stage_rc(tid * 16 + i * 8192, R, C); const int Rb = Epi::PERM ? ((R & ~31) + perm32(R & 31)) : R;
        voffA[i] = (unsigned)(R * K + C) * 2u; voffB[i] = (unsigned)(Rb * K + C) * 2u; }
    const size_t kstep = (size_t)(BK * 2);
    const size_t hstep = (size_t)HALF * K * 2;
    const size_t tstep = 2 * hstep;
    const unsigned ldsw = (unsigned)wid * 1024u;
    const int aoff = lds_byte(wr * 64 + fr, fq * 8), boff = lds_byte(wc * 32 + fr, fq * 8);
#define PG8_SA(b, h) (((b) * 2 + (h)) * HTB)
#define PG8_SB(b, h) ((4 + (b) * 2 + (h)) * HTB)
#define PG8_STAGE(bufoff, gbase, voff) do { _Pragma("unroll") for (int _i = 0; _i < 2; ++_i) \
        __builtin_amdgcn_global_load_lds((const unsigned*)((const char*)(gbase) + (voff)[_i]), (PG8_LAS unsigned*)(lds + (bufoff) + ldsw + _i * 8192), 16, 0, 0); } while (0)
#define PG8_LDA(dst, b, h) do { _Pragma("unroll") for (int m = 0; m < 4; ++m) _Pragma("unroll") for (int k = 0; k < 2; ++k) dst[m][k] = *(const PG8_LAS bf16x8*)(lds + PG8_SA(b, h) + aoff + m * 2048 + k * 1024); } while (0)
#define PG8_LDB(dst, b, h) do { _Pragma("unroll") for (int n = 0; n < 2; ++n) _Pragma("unroll") for (int k = 0; k < 2; ++k) dst[n][k] = *(const PG8_LAS bf16x8*)(lds + PG8_SB(b, h) + boff + n * 2048 + k * 1024); } while (0)
#define PG8_MMA(ai, bj, At, Bt) do { __builtin_amdgcn_s_setprio(1); _Pragma("unroll") for (int m = 0; m < 4; ++m) _Pragma("unroll") for (int n = 0; n < 2; ++n) _Pragma("unroll") for (int k = 0; k < 2; ++k) \
        acc[ai][bj][m][n] = __builtin_amdgcn_mfma_f32_16x16x32_bf16(Bt[n][k], At[m][k], acc[ai][bj][m][n], 0, 0, 0); __builtin_amdgcn_s_setprio(0); } while (0)
#define PG8_WAIT_V(n) asm volatile("s_waitcnt vmcnt(" #n ")" ::: "memory")
#define PG8_WAIT_L(n) asm volatile("s_waitcnt lgkmcnt(" #n ")" ::: "memory")
#define PG8_BAR __builtin_amdgcn_s_barrier()
#define PG8_SCHED __builtin_amdgcn_sched_barrier(0)
    Unit cur, nxt; int ui = 0;
    if (!S.next(0, cur)) return;
    f32x4 acc[2][2][4][2];
#pragma unroll
    for (int a = 0; a < 2; ++a)
#pragma unroll
        for (int b = 0; b < 2; ++b)
#pragma unroll
            for (int m = 0; m < 4; ++m)
#pragma unroll
                for (int n = 0; n < 2; ++n) acc[a][b][m][n] = (f32x4){0.f, 0.f, 0.f, 0.f};
    bf16x8 At[4][2], B0[2][2], B1[2][2];
    const char* cA = (const char*)g.A + (size_t)cur.pm * tstep; const char* cB = (const char*)g.Bt + (size_t)cur.pn * tstep;
    S.a_ready(cur);
    if constexpr (SP2) {
        PG8_STAGE(PG8_SB(0, 0), cB, voffB); PG8_STAGE(PG8_SB(0, 1), cB + hstep, voffB); PG8_STAGE(PG8_SA(0, 0), cA, voffA); PG8_STAGE(PG8_SA(0, 1), cA + hstep, voffA);
        if (wr == 1) PG8_BAR;
        PG8_WAIT_V(2); PG8_BAR;
        PG8_STAGE(PG8_SB(1, 0), cB + kstep, voffB); PG8_STAGE(PG8_SA(1, 0), cA + kstep, voffA); PG8_STAGE(PG8_SB(1, 1), cB + hstep + kstep, voffB);
        PG8_WAIT_V(6); PG8_BAR;
    } else {
        PG8_STAGE(PG8_SB(0, 0), cB, voffB); PG8_STAGE(PG8_SA(0, 0), cA, voffA); PG8_STAGE(PG8_SB(0, 1), cB + hstep, voffB); PG8_STAGE(PG8_SA(0, 1), cA + hstep, voffA);
        if (wr == 1) PG8_BAR;
        PG8_WAIT_V(4); PG8_BAR;
        PG8_STAGE(PG8_SB(1, 0), cB + kstep, voffB); PG8_STAGE(PG8_SA(1, 0), cA + kstep, voffA); PG8_STAGE(PG8_SB(1, 1), cB + hstep + kstep, voffB);
        PG8_WAIT_V(6); PG8_BAR;
    }
    for (;;) {
        const bool has_next = S.next(ui + 1, nxt);
        const char* nA = has_next ? (const char*)g.A + (size_t)nxt.pm * tstep : cA; const char* nB = has_next ? (const char*)g.Bt + (size_t)nxt.pn * tstep : cB;
        for (int t = 0; t < nt; t += 2) {
            const bool last = (t == nt - 2);
            const char* a1 = cA + (size_t)(t + 1) * kstep;
            const char* a2 = last ? nA : cA + (size_t)(t + 2) * kstep; const char* b2 = last ? nB : cB + (size_t)(t + 2) * kstep;
            const char* a3 = a2 + kstep; const char* b3 = b2 + kstep;
            if (last && has_next) S.a_ready(nxt);
            if constexpr (SP2) {
            PG8_LDB(B0, 0, 0); PG8_LDB(B1, 0, 1); PG8_SCHED; PG8_LDA(At, 0, 0); PG8_STAGE(PG8_SA(1, 1), a1 + hstep, voffA);
            PG8_WAIT_V(8); PG8_WAIT_L(0); PG8_BAR; PG8_MMA(0, 0, At, B0); PG8_MMA(0, 1, At, B1); PG8_BAR; PG8_SCHED;
            PG8_LDA(At, 0, 1); PG8_STAGE(PG8_SB(0, 0), b2, voffB); PG8_STAGE(PG8_SB(0, 1), b2 + hstep, voffB); PG8_STAGE(PG8_SA(0, 0), a2, voffA);
            PG8_WAIT_V(8); PG8_WAIT_L(0); PG8_BAR; PG8_MMA(1, 0, At, B0); PG8_MMA(1, 1, At, B1); PG8_BAR; PG8_SCHED;
            PG8_LDB(B0, 1, 0); PG8_LDB(B1, 1, 1); PG8_SCHED; PG8_LDA(At, 1, 0); PG8_STAGE(PG8_SA(0, 1), a2 + hstep, voffA);
            PG8_WAIT_V(8); PG8_WAIT_L(0); PG8_BAR; PG8_MMA(0, 0, At, B0); PG8_MMA(0, 1, At, B1); PG8_BAR; PG8_SCHED;
            PG8_LDA(At, 1, 1); PG8_STAGE(PG8_SB(1, 0), b3, voffB); PG8_STAGE(PG8_SB(1, 1), b3 + hstep, voffB); PG8_STAGE(PG8_SA(1, 0), a3, voffA);
            PG8_WAIT_V(8); PG8_WAIT_L(0); PG8_BAR; PG8_MMA(1, 0, At, B0); PG8_MMA(1, 1, At, B1); PG8_BAR; PG8_SCHED;
            } else {
            PG8_LDB(B0, 0, 0); PG8_SCHED; PG8_LDA(At, 0, 0); PG8_STAGE(PG8_SA(1, 1), a1 + hstep, voffA);
            PG8_WAIT_L(8); PG8_BAR; PG8_WAIT_L(0); PG8_MMA(0, 0, At, B0); PG8_BAR; PG8_SCHED;
            PG8_LDB(B1, 0, 1); PG8_STAGE(PG8_SB(0, 0), b2, voffB);
            PG8_BAR; PG8_WAIT_L(0); PG8_MMA(0, 1, At, B1); PG8_BAR;
            PG8_LDA(At, 0, 1); PG8_STAGE(PG8_SA(0, 0), a2, voffA);
            PG8_BAR; PG8_WAIT_L(0); PG8_MMA(1, 0, At, B0); PG8_BAR; PG8_SCHED;
            PG8_STAGE(PG8_SB(0, 1), b2 + hstep, voffB);
            PG8_WAIT_V(6); PG8_BAR; PG8_MMA(1, 1, At, B1); PG8_BAR;
            PG8_LDB(B0, 1, 0); PG8_SCHED; PG8_LDA(At, 1, 0); PG8_STAGE(PG8_SA(0, 1), a2 + hstep, voffA);
            PG8_WAIT_L(8); PG8_BAR; PG8_WAIT_L(0); PG8_MMA(0, 0, At, B0); PG8_BAR; PG8_SCHED;
            PG8_LDB(B1, 1, 1); PG8_STAGE(PG8_SB(1, 0), b3, voffB);
            PG8_BAR; PG8_WAIT_L(0); PG8_MMA(0, 1, At, B1); PG8_BAR;
            PG8_LDA(At, 1, 1); PG8_STAGE(PG8_SA(1, 0), a3, voffA);
            PG8_BAR; PG8_WAIT_L(0); PG8_MMA(1, 0, At, B0); PG8_BAR; PG8_SCHED;
            PG8_STAGE(PG8_SB(1, 1), b3 + hstep, voffB);
            PG8_WAIT_V(6); PG8_BAR; PG8_MMA(1, 1, At, B1); PG8_BAR;
            }
        }
        if constexpr (ALIGN_EPI) { if (wr == 0) PG8_BAR; }
        if constexpr (!Epi::AFTER_DRAIN) { E(acc, cur, wr, wc, fr, fq); S.done(cur); }
        if (!has_next) break;
#pragma unroll
        for (int a = 0; a < 2; ++a)
#pragma unroll
            for (int b = 0; b < 2; ++b)
#pragma unroll
                for (int m = 0; m < 4; ++m)
#pragma unroll
                    for (int n = 0; n < 2; ++n) acc[a][b][m][n] = (f32x4){0.f, 0.f, 0.f, 0.f};
        cur = nxt; cA = nA; cB = nB; ++ui;
        if constexpr (ALIGN_EPI) { if (wr == 1) PG8_BAR; }
    }
    PG8_WAIT_V(0);
    if constexpr (!ALIGN_EPI) { if (wr == 0) PG8_BAR; }
    PG8_BAR;
    if constexpr (Epi::AFTER_DRAIN) { E.fused(acc, cur, wr, wc, fr, fq, lds, wid, lane); S.done(cur); }
#undef PG8_SA
#undef PG8_SB
#undef PG8_STAGE
#undef PG8_LDA
#undef PG8_LDB
#undef PG8_MMA
#undef PG8_WAIT_V
#undef PG8_WAIT_L
#undef PG8_BAR
#undef PG8_SCHED
}
}
#ifndef PG8_SP2
#define PG8_SP2 true
#endif
#ifndef PG8_ALIGN
#define PG8_ALIGN true
#endif
constexpr int S_ = 8192, DM = 2048, DFF = 5632, NPROJ = 13056, NGU = 2 * DFF;
constexpr int IN_W = 12880;
constexpr int C_AQ = 0, C_AK = 1024, C_AV = 2048, C_IQ = 3072, C_BQ = 4096, C_BK = 5632, C_BV = 7168, C_GA = 8704, C_GB = 10752, C_IK = 12800, C_IW = 12864;
constexpr float ALPHA = 1.189207115002721f;
constexpr float LN_EPS = 1e-5f;
constexpr int TOPK = 256;

constexpr size_t MiB = 1u << 20;
constexpr size_t WS_CTL = 0, CTL_ZERO_BYTES = 256 * 1024;
constexpr size_t WS_WT_IN = 1 * MiB, WS_WT_A = 52 * MiB, WS_WT_B = 56 * MiB, WS_WT_OUT = 58 * MiB, WS_WT_GU = 66 * MiB, WS_WT_DOWN = 110 * MiB;
constexpr size_t WS_XB = 132 * MiB, WS_MERGED = 132 * MiB;
constexpr size_t WS_PROJ = 164 * MiB;
constexpr size_t WS_OA = 1 * MiB, WS_OB = 17 * MiB, WS_MASK = 25 * MiB, WS_SELCNT = 33 * MiB, WS_SELIDX = 34 * MiB, WS_OPA2 = 42 * MiB, WS_LSEA = 50 * MiB, WS_LSEB = 51 * MiB;
constexpr size_t WS_SELIDX2 = 42 * MiB, WS_SELCNT2 = 50 * MiB;
constexpr size_t WS_OPA0 = 132 * MiB, WS_OPA1 = 148 * MiB, WS_OPA3 = 160 * MiB;
constexpr size_t WS_OPB = 368 * MiB;
constexpr size_t WS_H = 164 * MiB, WS_HB = 228 * MiB, WS_ACT = 260 * MiB;
constexpr size_t WS_END = 392 * MiB;
static_assert(WS_WT_IN + (size_t)NPROJ * DM * 2 <= WS_WT_A && WS_WT_GU + (size_t)NGU * DM * 2 <= WS_WT_DOWN && WS_WT_DOWN + (size_t)DM * DFF * 2 <= WS_XB, "ws map 1");
static_assert(WS_PROJ + (size_t)S_ * NPROJ * 2 <= WS_OPB && WS_ACT + (size_t)S_ * DFF * 2 <= WS_OPB && WS_LSEB + 1 * MiB <= WS_WT_A, "ws map 2");

#define GAS __attribute__((address_space(1)))
#define LAS __attribute__((address_space(3)))
typedef unsigned short bf16;
typedef unsigned v4u __attribute__((ext_vector_type(4)));
typedef float f32x4 __attribute__((ext_vector_type(4)));
__device__ __forceinline__ unsigned f2bf(float f) { unsigned u = __builtin_bit_cast(unsigned, f); return (u + 0x7fffu + ((u >> 16) & 1u)) >> 16; }
__device__ __forceinline__ unsigned pk2(float lo, float hi) { return f2bf(lo) | (f2bf(hi) << 16); }
__device__ __forceinline__ float bf2f(bf16 v) { return __uint_as_float((unsigned)v << 16); }
__device__ __forceinline__ float wave_sum(float v) {
#pragma unroll
    for (int o = 1; o < 64; o <<= 1) v += __shfl_xor(v, o);
    return v;
}
__device__ __forceinline__ float wave_max(float v) {
#pragma unroll
    for (int o = 1; o < 64; o <<= 1) v = fmaxf(v, __shfl_xor(v, o));
    return v;
}

typedef short v4i16_t __attribute__((ext_vector_type(4)));
constexpr int TP_PITCH = 144;
__device__ __forceinline__ void transpose_item(const float* W, int Nsrc, int K, bf16* WT, int n0, int k0, int srccol0, int nvalid, LAS unsigned char* scr, int lane) {
    const int n4 = lane & 15, kr = lane >> 4;
    f32x4 v[16];
#pragma unroll
    for (int i = 0; i < 16; ++i) v[i] = (4 * n4 < nvalid) ? *(const f32x4*)(W + (size_t)(k0 + kr + 4 * i) * Nsrc + srccol0 + 4 * n4) : (f32x4){0.f, 0.f, 0.f, 0.f};
#pragma unroll
    for (int i = 0; i < 16; ++i) { unsigned long long w = (unsigned long long)pk2(v[i].x, v[i].y) | ((unsigned long long)pk2(v[i].z, v[i].w) << 32);
        *(LAS unsigned long long*)(scr + (kr + 4 * i) * TP_PITCH + n4 * 8) = w; }
    __builtin_amdgcn_s_waitcnt(0xc07f); asm volatile("" ::: "memory");
    const int g = lane >> 4, q = (lane >> 2) & 3, pp = lane & 3;
    const LAS unsigned char* rb = scr + q * TP_PITCH + (16 * g + 4 * pp) * 2;
    bf16* orow = WT + (size_t)(n0 + 16 * g + (lane & 15)) * K + k0;
#pragma unroll
    for (int kb = 0; kb < 16; kb += 2) {
        const v4i16_t a = __builtin_amdgcn_ds_read_tr16_b64_v4i16((LAS v4i16_t*)(rb + kb * 4 * TP_PITCH));
        const v4i16_t b2 = __builtin_amdgcn_ds_read_tr16_b64_v4i16((LAS v4i16_t*)(rb + (kb + 1) * 4 * TP_PITCH));
        v4u o; o.x = (unsigned)(unsigned short)a[0] | ((unsigned)(unsigned short)a[1] << 16); o.y = (unsigned)(unsigned short)a[2] | ((unsigned)(unsigned short)a[3] << 16);
        o.z = (unsigned)(unsigned short)b2[0] | ((unsigned)(unsigned short)b2[1] << 16); o.w = (unsigned)(unsigned short)b2[2] | ((unsigned)(unsigned short)b2[3] << 16);
        *(v4u*)(orow + 4 * kb) = o; }
    __builtin_amdgcn_s_waitcnt(0xc07f); asm volatile("" ::: "memory");
}
struct ProArgs { const float *x, *w_in, *w_a, *w_b, *w_out, *w_gate, *w_up, *w_down; unsigned char* ws; };
constexpr int I_IN = (DM / 64) * (NPROJ / 64), I_A = (1024 / 64) * (DM / 64), I_B = (512 / 64) * (DM / 64), I_OUT = (DM / 64) * (DM / 64), I_GU = (DM / 64) * (NGU / 64), I_DN = (DFF / 64) * (DM / 64);
constexpr int N_LATE_ITEMS = I_A + I_B + I_OUT + I_GU + I_DN;
static_assert(N_LATE_ITEMS % 8 == 0, "late items are dealt in chunks of 8 (one per wave)");
__device__ __forceinline__ void late_item(const ProArgs& a, int r, LAS unsigned char* scr, int lane) {
    bf16* wt_a = (bf16*)(a.ws + WS_WT_A); bf16* wt_b = (bf16*)(a.ws + WS_WT_B); bf16* wt_out = (bf16*)(a.ws + WS_WT_OUT); bf16* wt_gu = (bf16*)(a.ws + WS_WT_GU); bf16* wt_down = (bf16*)(a.ws + WS_WT_DOWN);
    if (r < I_A) { const int nb = r % (DM / 64), kb = r / (DM / 64); transpose_item(a.w_a, DM, 1024, wt_a, nb * 64, kb * 64, nb * 64, 64, scr, lane); return; }
    r -= I_A;
    if (r < I_B) { const int nb = r % (DM / 64), kb = r / (DM / 64); transpose_item(a.w_b, DM, 512, wt_b, nb * 64, kb * 64, nb * 64, 64, scr, lane); return; }
    r -= I_B;
    if (r < I_OUT) { const int nb = r % (DM / 64), kb = r / (DM / 64); transpose_item(a.w_out, DM, DM, wt_out, nb * 64, kb * 64, nb * 64, 64, scr, lane); return; }
    r -= I_OUT;
    if (r < I_GU) { const int nb = r % (NGU / 64), kb = r / (NGU / 64), n0 = nb * 64; const int half = (n0 >> 7) & 1, j = n0 >> 8, i = n0 & 127;
        transpose_item(half ? a.w_up : a.w_gate, DFF, DM, wt_gu, n0, kb * 64, 128 * j + i, 64, scr, lane); return; }
    r -= I_GU;
    { const int nb = r % (DM / 64), kb = r / (DM / 64); transpose_item(a.w_down, DM, DFF, wt_down, nb * 64, kb * 64, nb * 64, 64, scr, lane); }
}
__device__ __forceinline__ void prologue_body(const ProArgs& a, LAS unsigned char* scr  , int gw, int NGW, int lane) {
    bf16* wt_in = (bf16*)(a.ws + WS_WT_IN); bf16* xb = (bf16*)(a.ws + WS_XB);
    for (int r = gw; r < I_IN; r += NGW) { const int nb = r % (NPROJ / 64), kb = r / (NPROJ / 64), n0 = nb * 64;
        int src, nv = 64;
        if (n0 < 4096) src = n0; else if (n0 < 12800) src = n0 + 80; else if (n0 < 12880) { src = n0 - 12800 + 4096; nv = (12880 - n0) < 64 ? (12880 - n0) : 64; } else { src = 0; nv = 0; }
        transpose_item(a.w_in, IN_W, DM, wt_in, n0, kb * 64, src, nv, scr, lane); }
    for (int m = gw; m < S_; m += NGW) {
        const f32x4* xr = (const f32x4*)(a.x + (size_t)m * DM) + 2 * lane; v4u* o16 = (v4u*)(xb + (size_t)m * DM) + lane;
#pragma unroll
        for (int j = 0; j < 4; ++j) { const f32x4 v0 = xr[128 * j], v1 = xr[128 * j + 1]; v4u o; o.x = pk2(v0.x, v0.y); o.y = pk2(v0.z, v0.w); o.z = pk2(v1.x, v1.y); o.w = pk2(v1.z, v1.w); o16[64 * j] = o; }
    }
}
__device__ __forceinline__ void ln_row(const float* Y, const float* g, const float* b, float* outf, bf16* outb, int row, int lane) {
    const f32x4* yr = (const f32x4*)(Y + (size_t)row * DM) + lane;
    f32x4 v[8]; float s = 0.f;
#pragma unroll
    for (int j = 0; j < 8; ++j) { v[j] = yr[64 * j]; s += (v[j].x + v[j].y) + (v[j].z + v[j].w); }
    const float mean = wave_sum(s) * (1.f / DM); float s2 = 0.f;
#pragma unroll
    for (int j = 0; j < 8; ++j) { v[j] = v[j] - mean; s2 += (v[j].x * v[j].x + v[j].y * v[j].y) + (v[j].z * v[j].z + v[j].w * v[j].w); }
    const float rstd = 1.f / sqrtf(wave_sum(s2) * (1.f / DM) + LN_EPS);
#pragma unroll
    for (int j = 0; j < 8; ++j) { const f32x4 gg = ((const f32x4*)g)[lane + 64 * j], bb = ((const f32x4*)b)[lane + 64 * j]; const f32x4 o = v[j] * rstd * gg + bb;
        ((f32x4*)(outf + (size_t)row * DM))[lane + 64 * j] = o;
        if (outb) ((unsigned long long*)(outb + (size_t)row * DM))[lane + 64 * j] = (unsigned long long)pk2(o.x, o.y) | ((unsigned long long)pk2(o.z, o.w) << 32); }
}

__device__ __forceinline__ unsigned ord_key(float f) { unsigned u = __float_as_uint(f); return (u & 0x80000000u) ? ~u : (u | 0x80000000u); }
template <int NT> __device__ __forceinline__ unsigned block_exscan(unsigned v, unsigned* sh, unsigned* tot) {
    const int lane = threadIdx.x & 63, w = threadIdx.x >> 6;
    unsigned inc = v;
#pragma unroll
    for (int o = 1; o < 64; o <<= 1) { unsigned t = __shfl_up(inc, o); if (lane >= o) inc += t; }
    __syncthreads();
    if (lane == 63) sh[w] = inc;
    __syncthreads();
    unsigned base = 0, total = 0;
#pragma unroll
    for (int i = 0; i < NT / 64; ++i) { const unsigned s = sh[i]; if (i < w) base += s; total += s; }
    *tot = total;
    return base + inc - v;
}
constexpr int NTK_LDS_BYTES = (8192 + 1024 + 16 + 256 + 8 + 8) * 4;
template <int NT> __device__ __forceinline__ void naive_topk_query(int t, const bf16* proj, int* sel_idx, int* sel_cnt, float* ldsf) {
    float* sc = ldsf; float* qs = sc + 8192; float* wsh = qs + 1024; unsigned* hist = (unsigned*)(wsh + 16); unsigned* shs = hist + 256; unsigned* shp = shs + 8;
    const int tid = threadIdx.x; const int n = t + 1;
    const bf16* prow = proj + (size_t)t * NPROJ;
    __syncthreads();
    for (int i = tid; i < 1024; i += NT) qs[i] = bf2f(prow[C_IQ + i]);
    if (tid < 16) wsh[tid] = bf2f(prow[C_IW + tid]) * 0.25f;
    __syncthreads();
    for (int s = tid; s < n; s += NT) {
        const bf16* kr = proj + (size_t)s * NPROJ + C_IK; float kf[64];
#pragma unroll
        for (int i = 0; i < 8; ++i) { const v4u w = ((const v4u*)kr)[i];
            kf[8 * i + 0] = __uint_as_float(w.x << 16); kf[8 * i + 1] = __uint_as_float(w.x & 0xffff0000u); kf[8 * i + 2] = __uint_as_float(w.y << 16); kf[8 * i + 3] = __uint_as_float(w.y & 0xffff0000u);
            kf[8 * i + 4] = __uint_as_float(w.z << 16); kf[8 * i + 5] = __uint_as_float(w.z & 0xffff0000u); kf[8 * i + 6] = __uint_as_float(w.w << 16); kf[8 * i + 7] = __uint_as_float(w.w & 0xffff0000u); }
        float score = 0.f;
        for (int h = 0; h < 16; ++h) { float d = 0.f;
#pragma unroll
            for (int i = 0; i < 64; ++i) d = fmaf(qs[h * 64 + i], kf[i], d);
            score = fmaf(wsh[h], fmaxf(d * 0.125f, 0.f), score); }
        sc[s] = score;
    }
    __syncthreads();
    int* out = sel_idx + (size_t)t * TOPK;
    if (n <= TOPK) { if (tid < TOPK) out[tid] = tid < n ? tid : -1; if (tid == 0) sel_cnt[t] = n; return; }
    if (tid == 0) { shp[0] = 0u; shp[1] = TOPK; }
    unsigned maskbits = 0u;
    for (int round = 0; round < 4; ++round) {
        const int shift = 24 - 8 * round;
        if (tid < 256) hist[tid] = 0u;
        __syncthreads();
        const unsigned prefix = shp[0];
        for (int s = tid; s < n; s += NT) { const unsigned k = ord_key(sc[s]); if ((k & maskbits) == prefix) atomicAdd(&hist[(k >> shift) & 255u], 1u); }
        __syncthreads();
        if (tid == 0) { unsigned r = shp[1], cum = 0; int b = 255; for (; b > 0; --b) { if (cum + hist[b] >= r) break; cum += hist[b]; } shp[1] = r - cum; shp[0] = prefix | ((unsigned)b << shift); }
        maskbits |= 255u << shift;
        __syncthreads();
    }
    const unsigned tau = shp[0]; const unsigned rt = shp[1];
    constexpr int CH = S_ / NT;
    const int s0 = tid * CH;
    unsigned nt = 0;
    for (int i = 0; i < CH; ++i) { const int s = s0 + i; if (s < n && ord_key(sc[s]) == tau) ++nt; }
    unsigned tot; unsigned tr = block_exscan<NT>(nt, shs, &tot);
    unsigned ns = 0; unsigned flags = 0;
    for (int i = 0; i < CH; ++i) { const int s = s0 + i; if (s < n) { const unsigned k = ord_key(sc[s]); bool sel = k > tau; if (k == tau) { sel = tr < rt; ++tr; } if (sel) { flags |= 1u << i; ++ns; } } }
    unsigned sbase = block_exscan<NT>(ns, shs, &tot);
    for (int i = 0; i < CH; ++i) if (flags & (1u << i)) out[sbase++] = s0 + i;
    if (tid == 0) sel_cnt[t] = (int)tot;
}
constexpr int NAA_LDS_WAVE = (128 + 256 + 256) * 4;
__device__ __forceinline__ void naive_attn_a_wave(int t, int h, const bf16* proj, const int* sel_idx, const int* sel_cnt, bf16* oa, float* ldsw, int lane, unsigned* chk = nullptr) {
    float* q = ldsw; float* pw = q + 128; int* sel = (int*)(pw + 256);
    const bf16* prow = proj + (size_t)t * NPROJ;
    for (int i = lane; i < 128; i += 64) q[i] = bf2f(prow[C_AQ + h * 128 + i]);
    for (int i = lane; i < 256; i += 64) sel[i] = sel_idx[(size_t)t * TOPK + i];
    const int cnt = sel_cnt[t];
    __builtin_amdgcn_s_waitcnt(0xc07f); asm volatile("" ::: "memory");
    const float slope = exp2f(-0.4f * (float)(13 + h));
    float lg[4]; float mx = -INFINITY;
#pragma unroll
    for (int i = 0; i < 4; ++i) { const int k = lane + 64 * i; lg[i] = -INFINITY;
        if (k < cnt) { const int s = sel[k]; const v4u* kr = (const v4u*)(proj + (size_t)s * NPROJ + C_AK + h * 128); float d = 0.f;
            for (int c = 0; c < 16; ++c) { const v4u wv = kr[c];
                d = fmaf(q[8 * c + 0], __uint_as_float(wv.x << 16), d); d = fmaf(q[8 * c + 1], __uint_as_float(wv.x & 0xffff0000u), d);
                d = fmaf(q[8 * c + 2], __uint_as_float(wv.y << 16), d); d = fmaf(q[8 * c + 3], __uint_as_float(wv.y & 0xffff0000u), d);
                d = fmaf(q[8 * c + 4], __uint_as_float(wv.z << 16), d); d = fmaf(q[8 * c + 5], __uint_as_float(wv.z & 0xffff0000u), d);
                d = fmaf(q[8 * c + 6], __uint_as_float(wv.w << 16), d); d = fmaf(q[8 * c + 7], __uint_as_float(wv.w & 0xffff0000u), d); }
            lg[i] = d * 0.08838834764831845f - slope * (float)(t - s); }
        mx = fmaxf(mx, lg[i]); }
    mx = wave_max(mx); float sum = 0.f;
#pragma unroll
    for (int i = 0; i < 4; ++i) { lg[i] = (lane + 64 * i < cnt) ? __expf(lg[i] - mx) : 0.f; sum += lg[i]; }
    sum = wave_sum(sum); const float inv = 1.f / sum;
#pragma unroll
    for (int i = 0; i < 4; ++i) pw[lane + 64 * i] = lg[i] * inv;
    __builtin_amdgcn_s_waitcnt(0xc07f); asm volatile("" ::: "memory");
    float o0 = 0.f, o1 = 0.f;
    for (int k = 0; k < cnt; ++k) { const int s = sel[k]; const unsigned vv = *(const unsigned*)(proj + (size_t)s * NPROJ + C_AV + h * 128 + 2 * lane); const float p = pw[k];
        o0 = fmaf(p, __uint_as_float(vv << 16), o0); o1 = fmaf(p, __uint_as_float(vv & 0xffff0000u), o1); }
    if (chk) { const unsigned got = *(const unsigned*)(oa + (size_t)t * 1024 + h * 128 + 2 * lane); const float df = fmaxf(fabsf(__uint_as_float(got << 16) - o0), fabsf(__uint_as_float(got & 0xffff0000u) - o1));
        atomicMax(chk, __float_as_uint(wave_max(df))); }
    else *(unsigned*)(oa + (size_t)t * 1024 + h * 128 + 2 * lane) = pk2(o0, o1);
    __builtin_amdgcn_s_waitcnt(0xc07f); asm volatile("" ::: "memory");
}
constexpr int NAB_LDS_WAVE = (384 + 388) * 4;
__device__ __forceinline__ void naive_attn_b_wave(int t, int j, const bf16* proj, bf16* ob, float* ldsw, int lane, unsigned* chk = nullptr) {
    float* qsh = ldsw; float* pw = qsh + 384;
    const bf16* prow = proj + (size_t)t * NPROJ;
    for (int g = 0; g < 3; ++g) for (int i = lane; i < 128; i += 64) qsh[g * 128 + i] = bf2f(prow[C_BQ + (4 * g + j) * 128 + i]);
    __builtin_amdgcn_s_waitcnt(0xc07f); asm volatile("" ::: "memory");
    float mx = -INFINITY;
    for (int g = 0; g < 3; ++g) { const int d = g == 0 ? 1 : (g == 1 ? 4 : 16); const int m = t / d; const int nk = (m < 128 ? m : 128) + 1; const int head = 4 * g + j;
        const float slope = exp2f(-0.4f * (float)(head + 1)); const float* q = qsh + g * 128;
        for (int i = lane; i < 129; i += 64) { float l = -INFINITY;
            if (i < nk) { const int s = t - i * d; const v4u* kr = (const v4u*)(proj + (size_t)s * NPROJ + C_BK + head * 128); float dd = 0.f;
                for (int c = 0; c < 16; ++c) { const v4u wv = kr[c];
                    dd = fmaf(q[8 * c + 0], __uint_as_float(wv.x << 16), dd); dd = fmaf(q[8 * c + 1], __uint_as_float(wv.x & 0xffff0000u), dd);
                    dd = fmaf(q[8 * c + 2], __uint_as_float(wv.y << 16), dd); dd = fmaf(q[8 * c + 3], __uint_as_float(wv.y & 0xffff0000u), dd);
                    dd = fmaf(q[8 * c + 4], __uint_as_float(wv.z << 16), dd); dd = fmaf(q[8 * c + 5], __uint_as_float(wv.z & 0xffff0000u), dd);
                    dd = fmaf(q[8 * c + 6], __uint_as_float(wv.w << 16), dd); dd = fmaf(q[8 * c + 7], __uint_as_float(wv.w & 0xffff0000u), dd); }
                l = dd * 0.08838834764831845f - slope * (float)(i * d); }
            pw[g * 129 + i] = l; mx = fmaxf(mx, l); } }
    mx = wave_max(mx);
    __builtin_amdgcn_s_waitcnt(0xc07f); asm volatile("" ::: "memory");
    float sum = 0.f;
    for (int i = lane; i < 387; i += 64) { const float p = __expf(pw[i] - mx); pw[i] = p; sum += p; }
    sum = wave_sum(sum); const float inv = 1.f / sum;
    __builtin_amdgcn_s_waitcnt(0xc07f); asm volatile("" ::: "memory");
    float o0 = 0.f, o1 = 0.f;
    for (int g = 0; g < 3; ++g) { const int d = g == 0 ? 1 : (g == 1 ? 4 : 16); const int m = t / d; const int nk = (m < 128 ? m : 128) + 1; const int head = 4 * g + j;
        for (int i = 0; i < nk; ++i) { const int s = t - i * d; const unsigned vv = *(const unsigned*)(proj + (size_t)s * NPROJ + C_BV + head * 128 + 2 * lane); const float p = pw[g * 129 + i];
            o0 = fmaf(p, __uint_as_float(vv << 16), o0); o1 = fmaf(p, __uint_as_float(vv & 0xffff0000u), o1); } }
    if (chk) { const unsigned got = *(const unsigned*)(ob + (size_t)t * 512 + j * 128 + 2 * lane); const float df = fmaxf(fabsf(__uint_as_float(got << 16) - o0 * inv), fabsf(__uint_as_float(got & 0xffff0000u) - o1 * inv));
        atomicMax(chk, __float_as_uint(wave_max(df))); }
    else *(unsigned*)(ob + (size_t)t * 512 + j * 128 + 2 * lane) = pk2(o0 * inv, o1 * inv);
    __builtin_amdgcn_s_waitcnt(0xc07f); asm volatile("" ::: "memory");
}

constexpr int NWAVES = 8;
constexpr int RING_BYTES = 131072;
constexpr int LDSCTL_OFF = RING_BYTES, MISC_OFF = LDSCTL_OFF + 320;
constexpr int LDS_BYTES = 147456;
constexpr int CW_TMO = 0, CW_BAR = 4096;
typedef GAS unsigned gu32;
#define RLX_AGENT __ATOMIC_RELAXED, __HIP_MEMORY_SCOPE_AGENT
namespace tk {
typedef short bf16x8 __attribute__((ext_vector_type(8)));
typedef float f32x16 __attribute__((ext_vector_type(16)));
typedef float f32x2 __attribute__((ext_vector_type(2)));
constexpr int KT = 128, KT_BYTES = KT * 128, HIST_OFF = 2 * KT_BYTES, HIST_Q_BYTES = 4096, LDS_NEED = HIST_OFF + 16 * HIST_Q_BYTES;
constexpr int CAP = 512, LIST_OFF = HIST_OFF, LIST_Q_BYTES = CAP * 6, LMASK_OFF = LIST_OFF + 16 * LIST_Q_BYTES, LMASK_Q_BYTES = 1024;
static_assert(LMASK_OFF + 16 * LMASK_Q_BYTES <= LDS_NEED, "pass B overlay fits the histogram region");
constexpr int FLAG_OFF = 131072 + 320 + 64;
__device__ __forceinline__ int crow(int r, int hi) { return (r & 3) + 8 * (r >> 2) + 4 * hi; }
__device__ __forceinline__ unsigned okey(float f) { const int u = (int)__float_as_uint(f); return (unsigned)u ^ ((unsigned)(u >> 31) | 0x80000000u); }
__device__ __forceinline__ float vmax0(float a) { const int u = (int)__float_as_uint(a); return __uint_as_float((unsigned)(u > 0 ? u : 0)); }

constexpr unsigned KN0 = 0x3E800000u, KP0 = 0xBB800000u, FNB = 768u; constexpr int FSH = 17;
__device__ __forceinline__ unsigned fine_bin(unsigned key) {
    const unsigned a = ((key > KN0 ? key : KN0) - KN0) >> FSH, b = ((key > KP0 ? key : KP0) - KP0) >> FSH;
    return (a < FNB ? a : FNB) + (b < FNB ? b : FNB);
}
__device__ __forceinline__ bool fine_ok(unsigned bin) { return bin != 0u && bin != FNB && bin < 2u * FNB; }
__device__ __forceinline__ unsigned fine_lo(unsigned bin) { return bin < FNB ? KN0 + (bin << FSH) : KP0 + ((bin - FNB) << FSH); }
struct Lane {
    bf16x8 af[4]; float wv[16]; unsigned koff[4]; int kperm; unsigned lower; int tq;
};
struct PassArg {
    unsigned prefix, mbits, bmask; int shift; bool act;
    unsigned tau, req;
    unsigned bstar; bool allsel;
    unsigned run;
};
template <int MODE> __device__ __forceinline__ void pass(const Lane& L, const bf16* proj, unsigned* maskout, LAS unsigned char* lds, int nt, int tid, int lane, int wave, PassArg& A, int t0) {
    const int hi = lane >> 5, lam = lane & 31;
    LAS unsigned* hist = (LAS unsigned*)(lds + HIST_OFF + (wave * 2 + hi) * HIST_Q_BYTES);
    LAS unsigned char* lkeys = lds + LIST_OFF + (wave * 2 + hi) * LIST_Q_BYTES;
    LAS unsigned char* lmask = lds + LMASK_OFF + wave * 2 * LMASK_Q_BYTES;
    const int r0 = tid >> 3, c0 = tid & 7;
    const unsigned w0 = (unsigned)(r0 * 128 + 16 * (c0 ^ ((r0 >> 1) & 7))), w1 = w0 + 64 * 128;
    const unsigned goff0 = (unsigned)(r0 * NPROJ + c0 * 8) * 2u, goff1 = goff0 + 64u * NPROJ * 2u;
    const char* gt = (const char*)(proj + C_IK);
    v4u s0 = *(const v4u*)(gt + goff0), s1 = *(const v4u*)(gt + goff1);
    *(LAS v4u*)(lds + w0) = s0; *(LAS v4u*)(lds + w1) = s1;
    __syncthreads();
    unsigned run = 0;
    unsigned wq0h0 = 0, wq0h1 = 0, wq1h0 = 0, wq1h1 = 0;
    for (int i = 0; i < nt; ++i) {
        const bool more = (i + 1 < nt);
        if (more) { const char* g = gt + (size_t)(i + 1) * KT * NPROJ * 2; s0 = *(const v4u*)(g + goff0); s1 = *(const v4u*)(g + goff1); }
        LAS unsigned char* buf = lds + (i & 1) * KT_BYTES;
        f32x16 c[4]; bf16x8 kb[2][4];
#pragma unroll
        for (int ks = 0; ks < 4; ++ks) kb[0][ks] = *(const LAS bf16x8*)(buf + L.koff[ks]);
#pragma unroll
        for (int j = 0; j < 4; ++j) {
            if (j < 3) {
#pragma unroll
                for (int ks = 0; ks < 4; ++ks) kb[(j + 1) & 1][ks] = *(const LAS bf16x8*)(buf + L.koff[ks] + 4096 * (j + 1)); }
            __builtin_amdgcn_sched_barrier(0);
            c[j] = (f32x16){0.f, 0.f, 0.f, 0.f, 0.f, 0.f, 0.f, 0.f, 0.f, 0.f, 0.f, 0.f, 0.f, 0.f, 0.f, 0.f};
#pragma unroll
            for (int ks = 0; ks < 4; ++ks) c[j] = __builtin_amdgcn_mfma_f32_32x32x16_bf16(L.af[ks], kb[j & 1][ks], c[j], 0, 0, 0);
            __builtin_amdgcn_sched_barrier(0);
        }
#pragma unroll
        for (int j = 0; j < 4; ++j) {
            f32x2 sab = {0.f, 0.f};
#pragma unroll
            for (int r = 0; r < 16; r += 2) sab = __builtin_elementwise_fma((f32x2){L.wv[r], L.wv[r + 1]}, (f32x2){vmax0(c[j][r]), vmax0(c[j][r + 1])}, sab);
            float score = sab.x + sab.y;
            asm volatile("" : "+v"(score));
            const unsigned key = okey(score);
            const int s = i * KT + 32 * j + L.kperm;
            const bool valid = s <= L.tq;
            if (MODE == 0) {
                if (A.act && valid && ((key & A.mbits) == A.prefix)) { const unsigned bin = (key >> A.shift) & A.bmask; __hip_atomic_fetch_add(hist + (bin >> 1), 1u << (16 * (bin & 1)), __ATOMIC_RELAXED, __HIP_MEMORY_SCOPE_WORKGROUP); }
            } else if (MODE == 3) {
                if (valid) { const unsigned bin = fine_bin(key); __hip_atomic_fetch_add(hist + (bin >> 1), 1u << (16 * (bin & 1)), __ATOMIC_RELAXED, __HIP_MEMORY_SCOPE_WORKGROUP); }
            } else {
                bool sel;
                if (MODE == 1) {
                    const bool tie = valid && key == A.tau;
                    const unsigned long long tb = __ballot(tie);
                    sel = valid && key > A.tau;
                    if (tb) { const unsigned tb32 = hi ? (unsigned)(tb >> 32) : (unsigned)tb; const unsigned rank = run + __popc(tb32 & L.lower); if (tie && rank < A.req) sel = true; run += __popc(tb32); }
                } else {
                    const unsigned top = fine_bin(key);
                    sel = valid && (top > A.bstar || (top == A.bstar && A.allsel));
                    const bool cand = valid && top == A.bstar && !A.allsel;
                    const unsigned long long cb = __ballot(cand);
                    if (cb) { const unsigned cb32 = hi ? (unsigned)(cb >> 32) : (unsigned)cb; const unsigned slot = run + __popc(cb32 & ((1u << lam) - 1u));
                        if (cand && slot < (unsigned)CAP) { *(LAS unsigned*)(lkeys + slot * 4) = key; *(LAS unsigned short*)(lkeys + CAP * 4 + slot * 2) = (unsigned short)s; }
                        run += __popc(cb32); }
                }
                const unsigned long long sb = __ballot(sel);
                const unsigned q0 = (unsigned)sb, q1 = (unsigned)(sb >> 32);
                if ((j & 1) == 0) { wq0h0 = q0 & 0xffffu; wq0h1 = q0 >> 16; wq1h0 = q1 & 0xffffu; wq1h1 = q1 >> 16; }
                else { wq0h0 |= q0 << 16; wq0h1 |= q0 & 0xffff0000u; wq1h0 |= q1 << 16; wq1h1 |= q1 & 0xffff0000u;
                    if (lane < 4) { const unsigned v = lane == 0 ? wq0h0 : (lane == 1 ? wq0h1 : (lane == 2 ? wq1h0 : wq1h1));
                        if (MODE == 1) *(unsigned*)((char*)(maskout + ((size_t)t0 * 128 + (i * 2 + (j >> 1))) * 2) + (unsigned)((lane >> 1) * 1024 + (lane & 1) * 4)) = v;
                        else *(LAS unsigned*)(lmask + (lane >> 1) * LMASK_Q_BYTES + ((i * 2 + (j >> 1)) * 2 + (lane & 1)) * 4) = v; } }
            }
        }
        if (more) { LAS unsigned char* nb = lds + ((i + 1) & 1) * KT_BYTES; *(LAS v4u*)(nb + w0) = s0; *(LAS v4u*)(nb + w1) = s1; }
        __syncthreads();
    }
    A.run = run;
}
__device__ __forceinline__ bool hist_scan(LAS unsigned* hist, int lam, int hi, unsigned r, bool enabled, unsigned& fb, unsigned& fr, unsigned& fc) {
    unsigned cw[32]; unsigned sum = 0;
#pragma unroll
    for (int k = 0; k < 8; ++k) { const v4u v = *(const LAS v4u*)((LAS unsigned char*)hist + lam * 128 + 16 * k); cw[4 * k] = v.x; cw[4 * k + 1] = v.y; cw[4 * k + 2] = v.z; cw[4 * k + 3] = v.w; }
#pragma unroll
    for (int k = 0; k < 32; ++k) sum += (cw[k] & 0xffffu) + (cw[k] >> 16);
    unsigned suf = sum;
#pragma unroll
    for (int o = 1; o < 32; o <<= 1) { const unsigned tt = __shfl_down(suf, o, 32); if (lam + o < 32) suf += tt; }
    unsigned cum = suf - sum;
    const bool mine = enabled && cum < r && r <= suf;
    fb = 0; fr = 0; fc = 0;
    if (mine) {
#pragma unroll
        for (int k = 31; k >= 0; --k) {
            const unsigned chi = cw[k] >> 16, clo = cw[k] & 0xffffu;
            if (fc == 0 && cum + chi >= r) { fb = 2 * k + 1; fr = r - cum; fc = chi; } if (fc == 0) cum += chi;
            if (fc == 0 && cum + clo >= r) { fb = 2 * k; fr = r - cum; fc = clo; } if (fc == 0) cum += clo;
        }
        fb += 64 * lam;
    }
    const unsigned long long mb = __ballot(mine);
    const unsigned mb32 = hi ? (unsigned)(mb >> 32) : (unsigned)mb;
    if (mb32) { const int src = (hi << 5) + (__ffs(mb32) - 1); fb = __shfl(fb, src); fr = __shfl(fr, src); fc = __shfl(fc, src); }
    return mb32 != 0u;
}
__device__ __forceinline__ bool wg_any(bool p, LAS unsigned char* lds, int tid, int lane) {
    volatile LAS unsigned* flag = (volatile LAS unsigned*)(lds + FLAG_OFF);
    if (__ballot(p) != 0ull && lane == 0) *flag = 1u;
    __syncthreads();
    const unsigned any = *flag;
    __syncthreads();
    if (tid == 0) *flag = 0u;
    return any != 0u;
}
__device__ __forceinline__ void zero_hist(LAS unsigned char* lds, int wave, int lane) {
    LAS v4u* hz = (LAS v4u*)(lds + HIST_OFF + wave * 2 * HIST_Q_BYTES);
#pragma unroll
    for (int k = 0; k < 8; ++k) hz[lane + 64 * k] = (v4u){0u, 0u, 0u, 0u};
}
__device__ __forceinline__ void topk_block(int b, const bf16* proj, unsigned* maskout, LAS unsigned char* lds, int tid, int lane, int wave, unsigned& tacc) {
    const int lam = lane & 31, hi = lane >> 5;
    Lane L;
    L.kperm = crow(lam & 15, lam >> 4);
    const int t0 = 16 * b + 2 * wave; L.tq = t0 + hi;
    { const int qsel = (lam >> 2) & 1, head = (lam & 3) + 4 * (lam >> 3);
      const bf16* qp = proj + (size_t)(t0 + qsel) * NPROJ + C_IQ + head * 64 + 8 * hi;
#pragma unroll
      for (int ks = 0; ks < 4; ++ks) L.af[ks] = *(const bf16x8*)(qp + 16 * ks); }
    { const v4u a = *(const v4u*)(proj + (size_t)L.tq * NPROJ + C_IW), bq = *(const v4u*)(proj + (size_t)L.tq * NPROJ + C_IW + 8);
      const unsigned wd[8] = {a.x, a.y, a.z, a.w, bq.x, bq.y, bq.z, bq.w};
#pragma unroll
      for (int r = 0; r < 8; ++r) { L.wv[2 * r] = __uint_as_float(wd[r] << 16) * 0.03125f; L.wv[2 * r + 1] = __uint_as_float(wd[r] & 0xffff0000u) * 0.03125f; } }
    { const int sw = (L.kperm >> 1) & 7;
#pragma unroll
      for (int ks = 0; ks < 4; ++ks) L.koff[ks] = (unsigned)(L.kperm * 128 + 16 * ((2 * ks + hi) ^ sw)); }
    { unsigned lw = 0;
#pragma unroll 1
      for (int l2 = 0; l2 < 32; ++l2) if (crow(l2 & 15, l2 >> 4) < L.kperm) lw |= 1u << l2;
      L.lower = lw; }
    const int tmax = 16 * b + 15; const int nt = tmax / KT + 1; const int ntm = ((b >> 4) + 1) * 2;
    PassArg A{}; A.tau = 0u; A.req = 0xffffffffu;
    if (tmax >= TOPK) {
        LAS unsigned* hist = (LAS unsigned*)(lds + HIST_OFF + (wave * 2 + hi) * HIST_Q_BYTES);
        unsigned fb, fr, fc;
        zero_hist(lds, wave, lane);
        { TSTART(2); pass<3>(L, proj, maskout, lds, nt, tid, lane, wave, A, t0); TSTOP(2, tacc); }
        TSTART(3);
        const bool found = hist_scan(hist, lam, hi, TOPK, true, fb, fr, fc);
        const bool okf = found && fine_ok(fb) && (fc == fr || fc <= (unsigned)CAP);
        const bool generic = wg_any(!okf, lds, tid, lane);
        TSTOP(3, tacc);
        if (!generic) {
            const bool done = (fc == fr); const unsigned prefix = fine_lo(fb), r = fr;
            A.bstar = fb; A.allsel = done;
            { TSTART(4); pass<2>(L, proj, maskout, lds, ntm, tid, lane, wave, A, t0); TSTOP(4, tacc); }
            TSTART(5);
            LAS unsigned char* lkeys = lds + LIST_OFF + (wave * 2 + hi) * LIST_Q_BYTES;
            LAS unsigned* lm = (LAS unsigned*)(lds + LMASK_OFF + (wave * 2 + hi) * LMASK_Q_BYTES);
            const unsigned nc = done ? 0u : (A.run < (unsigned)CAP ? A.run : (unsigned)CAP);
            if (__ballot(nc != 0u)) {
                unsigned kk[16]; unsigned vm = 0u;
#pragma unroll
                for (int k = 0; k < 16; ++k) { kk[k] = ((const LAS unsigned*)lkeys + lam)[32 * k]; vm |= ((unsigned)(lam + 32 * k) < nc ? 1u : 0u) << k; }
                const unsigned ncw = __builtin_amdgcn_readfirstlane(nc) > (unsigned)__builtin_amdgcn_readlane((int)nc, 32) ? __builtin_amdgcn_readfirstlane(nc) : (unsigned)__builtin_amdgcn_readlane((int)nc, 32);
                const int kmaxw = (int)((ncw + 31u) >> 5);
                TSTART(6);
                unsigned cur = prefix;
                for (int bit = FSH - 1; bit >= 0; --bit) { const unsigned trial = cur | (1u << bit); unsigned cl = 0, ch = 0;
#pragma unroll
                    for (int k = 0; k < 16; ++k) if (k < kmaxw) { const unsigned long long m = __ballot(((vm >> k) & 1u) && kk[k] >= trial); cl += __popc((unsigned)m); ch += __popc((unsigned)(m >> 32)); }
                    if ((hi ? ch : cl) >= r) cur = trial; }
                TSTOP(6, tacc); TSTART(7);
                unsigned gl = 0, gh = 0, el = 0, eh = 0;
#pragma unroll
                for (int k = 0; k < 16; ++k) if (k < kmaxw) { const unsigned long long m = __ballot(((vm >> k) & 1u) && kk[k] > cur), m2 = __ballot(((vm >> k) & 1u) && kk[k] == cur);
                    gl += __popc((unsigned)m); gh += __popc((unsigned)(m >> 32)); el += __popc((unsigned)m2); eh += __popc((unsigned)(m2 >> 32)); }
                const unsigned req = r - (hi ? gh : gl);
                const bool rankties = (hi ? eh : el) > req;
#pragma unroll
                for (int k = 0; k < 16; ++k) if (k < kmaxw) { const unsigned s = ((const LAS unsigned short*)(lkeys + CAP * 4) + lam)[32 * k]; if ((vm >> k) & 1u) {
                        bool sel = kk[k] >= cur;
                        if (kk[k] == cur && rankties) { unsigned rank = 0; for (unsigned e2 = 0; e2 < nc; ++e2) { if (*(const LAS unsigned*)(lkeys + e2 * 4) == cur && (unsigned)*(const LAS unsigned short*)(lkeys + CAP * 4 + e2 * 2) < s) ++rank; } sel = rank < req; }
                        if (sel) { const unsigned k5 = s & 31u, jj = (s >> 5) & 1u, T = s >> 6; const unsigned word = T * 2 + ((k5 >> 2) & 1u), bitp = 16 * jj + (k5 & 3u) + 4 * (k5 >> 3);
                            __hip_atomic_fetch_or(lm + word, 1u << bitp, __ATOMIC_RELAXED, __HIP_MEMORY_SCOPE_WORKGROUP); } } }
                TSTOP(7, tacc);
            }
            TSTART(8);
            { LAS unsigned char* lmw = lds + LMASK_OFF + wave * 2 * LMASK_Q_BYTES;
#pragma unroll
              for (int q = 0; q < 2; ++q) if (lane < ntm) { const v4u v = *(const LAS v4u*)(lmw + q * LMASK_Q_BYTES + lane * 16); *(v4u*)((unsigned char*)maskout + (size_t)(t0 + q) * 1024 + lane * 16) = v; } }
            __syncthreads();
            TSTOP(8, tacc);
            TSTOP(5, tacc);
            return;
        }
#if DBG_COUNT
        if (tid == 0) atomicAdd(maskout - (WS_MASK / 4) + 16, DBG_COUNT == 1 ? 1u : (DBG_COUNT == 2 ? (unsigned)(!found) : (DBG_COUNT == 3 ? (unsigned)(found && !fine_ok(fb)) : (unsigned)(fc > (unsigned)CAP))));
#endif
        unsigned prefix = 0u, mbits = 0u, r = TOPK; bool done = false;
        for (int round = 0; round < 3; ++round) {
            const int shift = round == 0 ? 21 : (round == 1 ? 10 : 0); const unsigned bmask = round == 2 ? 1023u : 2047u;
            zero_hist(lds, wave, lane);
            A.prefix = prefix; A.mbits = mbits; A.shift = shift; A.bmask = bmask; A.act = !done;
            pass<0>(L, proj, maskout, lds, nt, tid, lane, wave, A, t0);
            if (hist_scan(hist, lam, hi, r, !done, fb, fr, fc)) { prefix |= fb << shift; r = fr; if (fc == fr) done = true; }
            mbits |= bmask << shift;
            if (!wg_any(!done, lds, tid, lane)) break;
        }
        A.tau = prefix; A.req = done ? 0xffffffffu : r;
    }
    pass<1>(L, proj, maskout, lds, ntm, tid, lane, wave, A, t0);
}
}
__device__ __forceinline__ void mask_to_list_wave(int t, const unsigned* mask, int* sel_idx, int* sel_cnt, int lane, unsigned* dbg_over = nullptr) {
    unsigned long long nat[2]; unsigned cnt[2];
#pragma unroll
    for (int i = 0; i < 2; ++i) { const int T = lane + 64 * i; unsigned long long m = 0ull;
        if (64 * T <= t) { const unsigned w0 = mask[((size_t)t * 128 + T) * 2], w1 = mask[((size_t)t * 128 + T) * 2 + 1];
            for (int bit = 0; bit < 32; ++bit) { const int j = bit >> 4, r = bit & 15;
                if ((w0 >> bit) & 1u) m |= 1ull << (32 * j + tk::crow(r, 0));
                if ((w1 >> bit) & 1u) m |= 1ull << (32 * j + tk::crow(r, 1)); } }
        nat[i] = m; cnt[i] = (unsigned)__popcll(m); }
    unsigned inc0 = cnt[0], inc1 = cnt[1];
#pragma unroll
    for (int o = 1; o < 64; o <<= 1) { const unsigned a = __shfl_up(inc0, o), b = __shfl_up(inc1, o); if (lane >= o) { inc0 += a; inc1 += b; } }
    const unsigned tot0 = __shfl(inc0, 63), tot1 = __shfl(inc1, 63);
    unsigned pos0 = inc0 - cnt[0], pos1 = tot0 + inc1 - cnt[1];
    for (int k = 0; k < 64; ++k) { if ((nat[0] >> k) & 1ull) { if (pos0 < TOPK) sel_idx[(size_t)t * TOPK + pos0] = 64 * lane + k; ++pos0; } }
    for (int k = 0; k < 64; ++k) { if ((nat[1] >> k) & 1ull) { if (pos1 < TOPK) sel_idx[(size_t)t * TOPK + pos1] = 64 * (lane + 64) + k; ++pos1; } }
    if (lane == 0) sel_cnt[t] = (int)((tot0 + tot1) < (unsigned)TOPK ? (tot0 + tot1) : (unsigned)TOPK);
    if (lane == 0 && dbg_over && tot0 + tot1 > (unsigned)TOPK) atomicAdd(dbg_over, 1u);
}
__device__ __forceinline__ void list_compare_wave(int t, const int* ia, const int* ca, const int* ib, const int* cb, unsigned* counter, int lane) {
    const int na = ca[t], nb = cb[t]; bool bad = na != nb;
    for (int i = lane; i < TOPK; i += 64) if (i < na && i < nb && ia[(size_t)t * TOPK + i] != ib[(size_t)t * TOPK + i]) bad = true;
    if (__ballot(bad) && lane == 0) atomicAdd(counter, 1u);
}
namespace at {
constexpr int NW = 8, QBLK = 32, KVBLK = 64, QB = NW * QBLK, D = 128;
constexpr int SHM_V = KVBLK * D * 2, SHM_K = KVBLK * D * 2;
constexpr int LDS_BYTES = 2 * SHM_V + 2 * SHM_K + NW * 64 * 4;
constexpr float SCALE = 0.08838834764831845f, THR = 8.f;
typedef short bf16x8 __attribute__((ext_vector_type(8)));
typedef short s16x4 __attribute__((ext_vector_type(4)));
typedef float f32x16 __attribute__((ext_vector_type(16)));
typedef unsigned u32x4 __attribute__((ext_vector_type(4)));
#define KSWZ(row, colB) ((row) * 256 + ((colB) ^ (((row) & 7) << 4)))
#define SBAR() __builtin_amdgcn_sched_barrier(0)
__device__ __forceinline__ int v_st(int k, int c) { const int kk = (k & ~0xC) | ((k & 4) << 1) | ((k & 8) >> 1); return ((kk >> 3) * 4 + (c >> 5)) * 512 + ((kk & 7) * 32 + (c & 31)) * 2; }
__device__ __forceinline__ int v_rd_base(int lane) { return ((lane & 3) << 3) | (((lane >> 2) & 3) << 6) | (((lane >> 4) & 1) << 5) | (((lane >> 5) & 1) << 8); }
constexpr int v_rd_off(int d0, int ks, int half) { return d0 * 512 + ks * 4096 + half * 2048; }
__device__ __forceinline__ int crow(int r, int hi) { return (r & 3) + 8 * (r >> 2) + 4 * hi; }
__device__ __forceinline__ unsigned cvtpk(float lo, float hi) { unsigned r; asm volatile("v_cvt_pk_bf16_f32 %0, %1, %2" : "=v"(r) : "v"(lo), "v"(hi)); return r; }
__device__ __forceinline__ void mask_tile(f32x16& p0, f32x16& p1, int dq, unsigned W) {
    const float NEG = -__builtin_inff();
#pragma unroll
    for (int r = 0; r < 16; ++r) { const int c = (r & 3) + 8 * (r >> 2);
        if ((unsigned)(dq - c) >= W) p0[r] = NEG;
        if ((unsigned)(dq - c - 32) >= W) p1[r] = NEG; }
}
__device__ __forceinline__ void partialSM(f32x16& p0, f32x16& p1, float& m_reg, float& mn, float& alpha) {
    float pmax = p0[0];
#pragma unroll
    for (int r = 1; r < 16; ++r) pmax = fmaxf(pmax, p0[r]);
#pragma unroll
    for (int r = 0; r < 16; ++r) pmax = fmaxf(pmax, p1[r]);
    { auto rr = __builtin_amdgcn_permlane32_swap(__float_as_uint(pmax), __float_as_uint(pmax), false, false);
      pmax = fmaxf(__uint_as_float(rr[0]), __uint_as_float(rr[1])); }
    constexpr float C2 = 1.4426950408889634f * SCALE;
    if (__builtin_expect(__all((pmax - m_reg) * SCALE <= THR), 1)) { mn = m_reg; alpha = 1.f; }
    else { mn = fmaxf(m_reg, pmax); alpha = __builtin_amdgcn_exp2f((m_reg - mn) * C2); m_reg = mn; }
    const float mnL = -mn * C2;
#pragma unroll
    for (int r = 0; r < 16; ++r) p0[r] = fmaf(p0[r], C2, mnL);
#pragma unroll
    for (int r = 0; r < 16; ++r) p1[r] = fmaf(p1[r], C2, mnL);
#pragma unroll
    for (int r = 0; r < 16; ++r) p0[r] = __builtin_amdgcn_exp2f(p0[r]);
}
__device__ __forceinline__ void finishSM(f32x16& p0, f32x16& p1, float alpha, float& l_reg, bf16x8& pa0, bf16x8& pa1, bf16x8& pa2, bf16x8& pa3) {
#pragma unroll
    for (int r = 0; r < 16; ++r) p1[r] = __builtin_amdgcn_exp2f(p1[r]);
    float ps = 0;
#pragma unroll
    for (int r = 0; r < 16; ++r) ps += p0[r];
#pragma unroll
    for (int r = 0; r < 16; ++r) ps += p1[r];
    { auto rr = __builtin_amdgcn_permlane32_swap(__float_as_uint(ps), __float_as_uint(ps), false, false);
      ps = __uint_as_float(rr[0]) + __uint_as_float(rr[1]); }
    l_reg = l_reg * alpha + ps;
#define PK4(P, B_, OUT) do { unsigned a0 = cvtpk(P[B_+0], P[B_+1]), a1 = cvtpk(P[B_+2], P[B_+3]);                          \
        unsigned b0 = cvtpk(P[B_+4], P[B_+5]), b1 = cvtpk(P[B_+6], P[B_+7]);                                             \
        auto r0 = __builtin_amdgcn_permlane32_swap(a0, b0, false, false); auto r1 = __builtin_amdgcn_permlane32_swap(a1, b1, false, false); \
        u32x4 w = {r0[0], r1[0], r0[1], r1[1]}; OUT = *reinterpret_cast<bf16x8*>(&w); } while (0)
    PK4(p0, 0, pa0); PK4(p0, 8, pa1); PK4(p1, 0, pa2); PK4(p1, 8, pa3);
#undef PK4
}
template <int KB>
__device__ __forceinline__ void qkt(f32x16& p0, f32x16& p1, const f32x16& i0, const f32x16& i1, const char* K_lds, int kbase  , const bf16x8* qr) {
    p0 = i0; p1 = i1;
    asm volatile("" : "+v"(kbase));
    const char* kb[4];
#pragma unroll
    for (int dd = 0; dd < 4; ++dd) kb[dd] = K_lds + KB * SHM_K + (kbase ^ (dd << 5));
#pragma unroll
    for (int d0 = 0; d0 < 8; ++d0) { const char* a = kb[d0 & 3] + (d0 >> 2) * 128;
        bf16x8 b0 = *reinterpret_cast<const bf16x8*>(a);
        bf16x8 b1 = *reinterpret_cast<const bf16x8*>(a + 32 * 256);
        p0 = __builtin_amdgcn_mfma_f32_32x32x16_bf16(b0, qr[d0], p0, 0, 0, 0);
        p1 = __builtin_amdgcn_mfma_f32_32x32x16_bf16(b1, qr[d0], p1, 0, 0, 0); }
}
template <int VB>
__device__ __forceinline__ void pv_tile(f32x16* o, int vb0, bf16x8 pa0, bf16x8 pa1, bf16x8 pa2, bf16x8 pa3) {
#define TRRD(dst, off) asm volatile("ds_read_b64_tr_b16 %0, %1 offset:%2" : "=&v"(dst) : "v"(vb0), "i"(off) : "memory")
#define PV_D0(d0) do { s16x4 l0, l1, l2, l3, h0, h1, h2, h3; constexpr int b_ = VB * SHM_V + v_rd_off(d0, 0, 0); \
        TRRD(l0, b_); TRRD(h0, b_ + 2048); TRRD(l1, b_ + 4096); TRRD(h1, b_ + 6144); TRRD(l2, b_ + 8192); TRRD(h2, b_ + 10240); TRRD(l3, b_ + 12288); TRRD(h3, b_ + 14336); \
        asm volatile("s_waitcnt lgkmcnt(0)" ::: "memory"); SBAR();   \
        o[d0] = __builtin_amdgcn_mfma_f32_32x32x16_bf16(pa0, (bf16x8){l0[0], l0[1], l0[2], l0[3], h0[0], h0[1], h0[2], h0[3]}, o[d0], 0, 0, 0);   \
        o[d0] = __builtin_amdgcn_mfma_f32_32x32x16_bf16(pa1, (bf16x8){l1[0], l1[1], l1[2], l1[3], h1[0], h1[1], h1[2], h1[3]}, o[d0], 0, 0, 0);   \
        o[d0] = __builtin_amdgcn_mfma_f32_32x32x16_bf16(pa2, (bf16x8){l2[0], l2[1], l2[2], l2[3], h2[0], h2[1], h2[2], h2[3]}, o[d0], 0, 0, 0);   \
        o[d0] = __builtin_amdgcn_mfma_f32_32x32x16_bf16(pa3, (bf16x8){l3[0], l3[1], l3[2], l3[3], h3[0], h3[1], h3[2], h3[3]}, o[d0], 0, 0, 0); } while (0)
    PV_D0(0); PV_D0(1); PV_D0(2); PV_D0(3);
#undef PV_D0
#undef TRRD
}
struct Unit {
    const bf16* Q; const bf16* K; const bf16* V; size_t ld; int P0, j_lo, j_hi;
    float slopeR;
    const unsigned* mrow;
};
struct UnitOut { bf16* O; size_t ldo; float* lse; int ldl; };

template <int MODE> __device__ __forceinline__ void make_init(f32x16& i0, f32x16& i1, float slopeR, int kb, int hi, unsigned mw, int dq, unsigned W) {
    const float base = slopeR * (float)(kb + 4 * hi); const float NEG = -__builtin_inff();
#pragma unroll
    for (int r = 0; r < 16; ++r) { const int ci = (r & 3) + 8 * (r >> 2); const float c = (float)ci;
        float b0 = fmaf(slopeR, c, base), b1 = fmaf(slopeR, c + 32.f, base);
        if (MODE == 0) { b0 = ((mw >> r) & 1u) ? b0 : NEG; b1 = ((mw >> (16 + r)) & 1u) ? b1 : NEG; }
        else { if ((unsigned)(dq - ci) >= W) b0 = NEG; if ((unsigned)(dq - ci - 32) >= W) b1 = NEG; }
        i0[r] = b0; i1[r] = b1; }
}
#define VMW() asm volatile("s_waitcnt vmcnt(0)" ::: "memory")
#define SLOAD_H(k0) do { const size_t tb_ = (size_t)(k0) * ldb; const char* kt_ = (const char*)U.K + tb_; const char* vt_ = (const char*)U.V + tb_; \
        st_v0 = *(const bf16x8*)(vt_ + soff0); st_v1 = *(const bf16x8*)(vt_ + soff1); st_k0 = *(const bf16x8*)(kt_ + soff0); st_k1 = *(const bf16x8*)(kt_ + soff1); } while (0)
#define SWRITE_HK(bf) do { *(bf16x8*)(K_lds + (bf) * SHM_K + kws) = st_k0; *(bf16x8*)(K_lds + (bf) * SHM_K + kws + 32 * 256) = st_k1; } while (0)
#define SWRITE_HV(bf) do { *(bf16x8*)(V_lds + (bf) * SHM_V + vst0) = st_v0; *(bf16x8*)(V_lds + (bf) * SHM_V + vst1) = st_v1; } while (0)
#define SWRITE_H(bf) do { SWRITE_HV(bf); SWRITE_HK(bf); } while (0)
template <int MODE  , class OutFn>
__device__ __forceinline__ void attn_unit(const Unit& U, int W, char* lds, const OutFn& outfn) {
    const int tid = threadIdx.x, wid = __builtin_amdgcn_readfirstlane(tid >> 6), lane = tid & 63, r32 = lane & 31, hi = lane >> 5;
    const size_t ldb = U.ld * 2;
    const int NT = U.j_hi - U.j_lo;
    const int qlo = U.P0 + wid * QBLK, qm = qlo + r32 - 4 * hi;
    char* V_lds = lds; char* K_lds = lds + 2 * SHM_V;
    float* ws = (float*)(lds + 2 * SHM_V + 2 * SHM_K) + wid * 64; float* li_l = ws, * al_l = ws + 32;
    float m_reg = -1e30f, l_reg = 0; f32x16 o[4] = {};
    const int sr = tid >> 4, sc = (tid & 15) * 8, vst0 = v_st(sr, sc), vst1 = v_st(32 + sr, sc), kws = KSWZ(sr, sc * 2);
    const unsigned soff0 = (unsigned)(sr * (unsigned)ldb + sc * 2), soff1 = soff0 + 32u * (unsigned)ldb;
    const int vb0 = (int)(uintptr_t)V_lds + v_rd_base(lane);
    const int kbase = KSWZ(r32, hi * 16);
    bf16x8 qr[8]; bf16x8 st_v0, st_v1, st_k0, st_k1;
    const unsigned moff = (unsigned)(((wid * QBLK + r32) * 128) * 2 + hi) * 4u;
#define RESC(a) do { if (__any((a) < 1.f)) { if (hi == 0) al_l[r32] = (a); asm volatile("s_waitcnt lgkmcnt(0)" ::: "memory");              \
                     for (int d_ = 0; d_ < 4; ++d_) for (int r = 0; r < 16; ++r) o[d_][r] *= al_l[crow(r, hi)]; } } while (0)
#define KBASE(t) ((U.j_lo + (t)) * KVBLK)
#define MASKT(P0_, P1_, t) do { } while (0)
#define MWLOAD(t) ((MODE == 0) ? *(const unsigned*)((const char*)U.mrow + (size_t)(U.j_lo + (t)) * 8 + moff) : 0u)
#define QKT(KB, PX0, PX1, t, mw_) do { f32x16 i0_, i1_; int ln_ = lane; asm volatile("" : "+v"(ln_)); make_init<MODE>(i0_, i1_, U.slopeR, KBASE(t), hi, (mw_), qlo + (ln_ & 31) - 4 * (ln_ >> 5) - KBASE(t), (unsigned)W); qkt<KB>(PX0, PX1, i0_, i1_, K_lds, kbase, qr); } while (0)
#pragma unroll
    for (int d0 = 0; d0 < 8; ++d0) qr[d0] = *(const bf16x8*)((const char*)U.Q + (unsigned)((wid * QBLK + r32) * (unsigned)ldb + (d0 * 16 + hi * 8) * 2));
    unsigned mwA = MWLOAD(0), mwB = 0u;
    SLOAD_H(KBASE(0)); VMW(); SWRITE_H(0);
    __syncthreads();
    f32x16 pA0, pA1, pB0, pB1; float mnA, mnB, alA, alB; bf16x8 pa0, pa1, pa2, pa3;
    if (NT > 1) { SLOAD_H(KBASE(1)); mwB = MWLOAD(1); }
    SBAR(); QKT(0, pA0, pA1, 0, mwA);
    MASKT(pA0, pA1, 0); partialSM(pA0, pA1, m_reg, mnA, alA);
    if (NT > 1) { VMW(); SWRITE_H(1); }
    __syncthreads();
#define HALF_STEP(PX0, PX1, mnX, alX, PY0, PY1, alY, t, KB, VB, SB, mwX, mwY) do {                                        \
        SBAR(); QKT(KB, PX0, PX1, t, mwX);                                                                                  \
        finishSM(PY0, PY1, alY, l_reg, pa0, pa1, pa2, pa3); SBAR();                                                           \
        if ((t) + 1 < NT) { SLOAD_H(KBASE((t) + 1)); mwY = MWLOAD((t) + 1); SBAR(); }                                       \
        pv_tile<VB>(o, vb0, pa0, pa1, pa2, pa3); MASKT(PX0, PX1, (t)); partialSM(PX0, PX1, m_reg, mnX, alX);              \
        __syncthreads();                                                                                                      \
        if ((t) + 1 < NT) { VMW(); SWRITE_H(SB); }                                                                            \
        RESC(alX); __syncthreads(); } while (0)
    for (int t = 1; t + 1 < NT; t += 2) {
        HALF_STEP(pB0, pB1, mnB, alB, pA0, pA1, alA, t, 1, 0, 0, mwB, mwA);
        HALF_STEP(pA0, pA1, mnA, alA, pB0, pB1, alB, t + 1, 0, 1, 1, mwA, mwB);
    }
    const bool even = (NT & 1) == 0;
    if (even) { SBAR(); QKT(1, pB0, pB1, NT - 1, mwB); SBAR(); }
    finishSM(pA0, pA1, alA, l_reg, pa0, pa1, pa2, pa3); SBAR();
    pv_tile<0>(o, vb0, pa0, pa1, pa2, pa3);
    if (even) { MASKT(pB0, pB1, NT - 1); partialSM(pB0, pB1, m_reg, mnB, alB); __syncthreads(); RESC(alB);
        finishSM(pB0, pB1, alB, l_reg, pa0, pa1, pa2, pa3); SBAR(); pv_tile<1>(o, vb0, pa0, pa1, pa2, pa3); }
    if (hi == 0) li_l[r32] = l_reg; asm volatile("s_waitcnt lgkmcnt(0)" ::: "memory");
    float rli[16];
#pragma unroll
    for (int r = 0; r < 16; ++r) { const float lv = li_l[crow(r, hi)]; rli[r] = lv > 0.f ? __builtin_amdgcn_rcpf(lv) : 0.f; }
    const UnitOut UO = outfn();
    bf16* Ow = UO.O + (size_t)(wid * QBLK) * UO.ldo;
#pragma unroll
    for (int r = 0; r < 16; ++r) { const int orow = crow(r, hi);
#pragma unroll
        for (int d0 = 0; d0 < 4; ++d0) { const float v = o[d0][r] * rli[r]; const float vn = __shfl_xor(v, 1);
            if ((r32 & 1) == 0) *(unsigned*)(Ow + (size_t)orow * UO.ldo + d0 * 32 + r32) = cvtpk(v, vn); } }
    if (hi == 0) { constexpr float C2 = 1.4426950408889634f * SCALE;
        const float lse2 = l_reg > 0.f ? (m_reg - U.slopeR * (float)(qlo + r32)) * C2 + __builtin_amdgcn_logf(l_reg) : -__builtin_inff();
        UO.lse[(size_t)(wid * QBLK + r32) * UO.ldl] = lse2; }
    __syncthreads();
#undef RESC
#undef KBASE
#undef MASKT
#undef MWLOAD
#undef QKT
#undef HALF_STEP
}
#undef ROW
#undef VMW
#undef SLOAD_H
#undef SWRITE_HK
#undef SWRITE_HV
#undef SWRITE_H
#undef KSWZ
#undef SBAR
}
constexpr int N_ATTN_UNITS = 1024;
struct AttnBufs { const bf16* proj; const unsigned* mask; bf16* opa[4]; float* lsea; bf16* opb; float* lseb; };
__device__ __forceinline__ AttnBufs attn_bufs(unsigned char* ws) { return AttnBufs{(const bf16*)(ws + WS_PROJ), (const unsigned*)(ws + WS_MASK), {(bf16*)(ws + WS_OPA0), (bf16*)(ws + WS_OPA1), (bf16*)(ws + WS_OPA2), (bf16*)(ws + WS_OPA3)}, (float*)(ws + WS_LSEA), (bf16*)(ws + WS_OPB), (float*)(ws + WS_LSEB)}; }
__device__ __forceinline__ int opa_rowoff(int c) { return c == 0 ? 0 : (c == 1 ? 8192 : (c == 2 ? 14336 : 18432)); }
__device__ __forceinline__ size_t opa_base(int c) { return c == 0 ? WS_OPA0 : (c == 1 ? WS_OPA1 : (c == 2 ? WS_OPA2 : WS_OPA3)); }
struct UnitId { int mode, h, qb, c, t0, t1; };
__device__ __forceinline__ UnitId attn_unit_id(int u) {
    UnitId I;
    if (u < 640) { I.mode = 0;
        if (u < 416) { I.h = u / 52; int v = u % 52; int qb = 31, c = 0; for (;; --qb) { const int cnt = (qb + 1) >> 3; if (v < cnt) { c = v; break; } v -= cnt; } I.qb = qb; I.c = c; I.t0 = 32 * c; I.t1 = I.t0 + 32; }
        else { const int w = u - 416, k = 7 - w / 32, e = w % 32; I.h = e >> 2; I.c = e & 3; I.qb = k - 1 + 8 * I.c; I.t0 = 32 * I.c; I.t1 = I.t0 + 4 * k; }
    } else { I.mode = 1; const int w = u - 640; I.h = w >> 5; const int idx = w & 31, g = I.h >> 2, d = 1 << (2 * g), nqb = 32 / d; I.c = idx / nqb  ; I.qb = idx % nqb; I.t0 = 0; I.t1 = 0; }
    return I;
}
__device__ __forceinline__ void attn_decode_in(const UnitId& I, at::Unit& U, unsigned char* ws) {
    const bf16* proj = (const bf16*)(ws + WS_PROJ);
    if (I.mode == 0) {
        U.Q = proj + (size_t)(256 * I.qb) * NPROJ + C_AQ + I.h * 128; U.K = proj + C_AK + I.h * 128; U.V = proj + C_AV + I.h * 128; U.ld = NPROJ; U.P0 = 256 * I.qb; U.j_lo = I.t0; U.j_hi = I.t1;
        U.slopeR = exp2f(-0.4f * (float)(13 + I.h)) * (1.0f / at::SCALE);
        U.mrow = (const unsigned*)(ws + WS_MASK) + (size_t)(256 * I.qb) * 256;
    } else {
        const int g = I.h >> 2, d = 1 << (2 * g), P0 = 256 * I.qb; const size_t tok0 = (size_t)P0 * d + I.c;
        U.Q = proj + tok0 * NPROJ + C_BQ + I.h * 128; U.K = proj + (size_t)I.c * NPROJ + C_BK + I.h * 128; U.V = proj + (size_t)I.c * NPROJ + C_BV + I.h * 128; U.ld = (size_t)d * NPROJ; U.P0 = P0;
        U.j_lo = (P0 >= 128 ? P0 - 128 : 0) / 64; U.j_hi = (P0 + 255) / 64 + 1;
        U.slopeR = exp2f(-0.4f * (float)(I.h + 1)) * (float)d * (1.0f / at::SCALE);
        U.mrow = nullptr;
    }
}
__device__ __forceinline__ at::UnitOut attn_decode_out(const UnitId& I, unsigned char* ws) {
    at::UnitOut O;
    if (I.mode == 0) { const int row = 256 * I.qb - 2048 * I.c;
        O.O = (bf16*)(ws + opa_base(I.c)) + (size_t)row * 1024 + I.h * 128; O.ldo = 1024; O.lse = (float*)(ws + WS_LSEA) + (size_t)(opa_rowoff(I.c) + row) * 8 + I.h; O.ldl = 8;
    } else { const int g = I.h >> 2, j = I.h & 3, d = 1 << (2 * g); const size_t tok0 = (size_t)(256 * I.qb) * d + I.c;
        O.O = (bf16*)(ws + WS_OPB) + (size_t)g * S_ * 512 + tok0 * 512 + j * 128; O.ldo = (size_t)d * 512; O.lse = (float*)(ws + WS_LSEB) + (size_t)g * S_ * 4 + tok0 * 4 + j; O.ldl = 4 * d; }
    return O;
}
__device__ __forceinline__ void attn_run_unit(int u, unsigned char* ws, char* lds) {
    const UnitId I = attn_unit_id(u);
    at::Unit U; attn_decode_in(I, U, ws);
    auto outfn = [u, ws]() { int u2 = u; asm volatile("" : "+s"(u2)); const UnitId I2 = attn_unit_id(u2); return attn_decode_out(I2, ws); };
    if (I.mode == 0) at::attn_unit<0>(U, 0, lds, outfn); else at::attn_unit<1>(U, 129, lds, outfn);
}
__device__ __forceinline__ void combine_token(int t, const AttnBufs& B, bf16* oa, bf16* ob, int lane) {
    { const int h = lane >> 3, e0 = (lane & 7) * 16; const int nc = (t >> 11) + 1;
      float ls[4]; float mx = -INFINITY;
#pragma unroll
      for (int c = 0; c < 4; ++c) { ls[c] = c < nc ? B.lsea[(size_t)(opa_rowoff(c) + t - 2048 * c) * 8 + h] : -INFINITY; mx = fmaxf(mx, ls[c]); }
      float acc[16]; float den = 0.f;
#pragma unroll
      for (int i = 0; i < 16; ++i) acc[i] = 0.f;
#pragma unroll
      for (int c = 0; c < 4; ++c) { if (c < nc) { const float wgt = exp2f(ls[c] - mx); den += wgt;
              const v4u* p = (const v4u*)(B.opa[c] + (size_t)(t - 2048 * c) * 1024 + h * 128 + e0); const v4u a = p[0], b = p[1];
              const unsigned wd[8] = {a.x, a.y, a.z, a.w, b.x, b.y, b.z, b.w};
#pragma unroll
              for (int i = 0; i < 8; ++i) { acc[2 * i] = fmaf(wgt, __uint_as_float(wd[i] << 16), acc[2 * i]); acc[2 * i + 1] = fmaf(wgt, __uint_as_float(wd[i] & 0xffff0000u), acc[2 * i + 1]); } } }
      const float inv = 1.f / den;
      v4u o0, o1; o0.x = pk2(acc[0] * inv, acc[1] * inv); o0.y = pk2(acc[2] * inv, acc[3] * inv); o0.z = pk2(acc[4] * inv, acc[5] * inv); o0.w = pk2(acc[6] * inv, acc[7] * inv);
      o1.x = pk2(acc[8] * inv, acc[9] * inv); o1.y = pk2(acc[10] * inv, acc[11] * inv); o1.z = pk2(acc[12] * inv, acc[13] * inv); o1.w = pk2(acc[14] * inv, acc[15] * inv);
      v4u* q = (v4u*)(oa + (size_t)t * 1024 + h * 128 + e0); q[0] = o0; q[1] = o1; }
    { const int j = lane >> 4, e0 = (lane & 15) * 8;
      float ls[3]; float mx = -INFINITY;
#pragma unroll
      for (int g = 0; g < 3; ++g) { ls[g] = B.lseb[(size_t)g * S_ * 4 + (size_t)t * 4 + j]; mx = fmaxf(mx, ls[g]); }
      float acc[8]; float den = 0.f;
#pragma unroll
      for (int i = 0; i < 8; ++i) acc[i] = 0.f;
#pragma unroll
      for (int g = 0; g < 3; ++g) { const float wgt = exp2f(ls[g] - mx); den += wgt;
          const v4u a = *(const v4u*)(B.opb + (size_t)g * S_ * 512 + (size_t)t * 512 + j * 128 + e0); const unsigned wd[4] = {a.x, a.y, a.z, a.w};
#pragma unroll
          for (int i = 0; i < 4; ++i) { acc[2 * i] = fmaf(wgt, __uint_as_float(wd[i] << 16), acc[2 * i]); acc[2 * i + 1] = fmaf(wgt, __uint_as_float(wd[i] & 0xffff0000u), acc[2 * i + 1]); } }
      const float inv = 1.f / den;
      v4u o; o.x = pk2(acc[0] * inv, acc[1] * inv); o.y = pk2(acc[2] * inv, acc[3] * inv); o.z = pk2(acc[4] * inv, acc[5] * inv); o.w = pk2(acc[6] * inv, acc[7] * inv);
      *(v4u*)(ob + (size_t)t * 512 + j * 128 + e0) = o; }
}
#define XB_TMO      128
#define XB_XCNT(j)  (256  + 64 * (j))
#define XB_XSUB(j)  (1280 + 64 * (j))
#define XB_XGEN(j)  (2304 + 64 * (j))
#define XB_TOP      3328
#define XB_TOPGEN   3392
#define XCD_BAR_WORDS 3456
#define XB_SPIN_CAP (1u << 22)

__device__ __forceinline__ unsigned xb_ld(unsigned* p)              { return __hip_atomic_load(p, __ATOMIC_RELAXED, __HIP_MEMORY_SCOPE_AGENT); }
__device__ __forceinline__ unsigned xb_add(unsigned* p, unsigned v) { return __hip_atomic_fetch_add(p, v, __ATOMIC_RELAXED, __HIP_MEMORY_SCOPE_AGENT); }
__device__ __forceinline__ unsigned xb_xcc_id() { return (unsigned)__builtin_amdgcn_s_getreg((3 << 11) | 20) & 0xFu; }
#define XB_SPIN(cond, bar) do { unsigned _sp = 0; while (cond) { __builtin_amdgcn_s_sleep(1); \
    if ((++_sp & 255u) == 0u) { if (xb_ld(&(bar)[XB_TMO])) break; if (_sp > XB_SPIN_CAP) { atomicAdd(&(bar)[XB_TMO], 1u); break; } } } } while (0)

struct XcdBarrier {
    unsigned* bar; unsigned x;
    volatile LAS unsigned* st;
};

__device__ __forceinline__ XcdBarrier xcd_barrier_post(unsigned* bar, volatile LAS unsigned* st) {
    XcdBarrier b; b.bar = bar; b.x = xb_xcc_id(); b.st = st;
    if (threadIdx.x == 0) (void)xb_add(&bar[XB_XCNT(b.x)], 1u);
    return b;
}
__device__ __forceinline__ void xcd_barrier_complete(unsigned* bar, unsigned x, unsigned& nloc, unsigned& nx) {
    const unsigned G = gridDim.x * gridDim.y * gridDim.z;
    unsigned sum, cnt, mine, sp = 0u;
    for (;;) {
        sum = 0u; cnt = 0u; mine = 0u;
#pragma unroll
        for (unsigned j = 0; j < 16; ++j) { const unsigned c = xb_ld(&bar[XB_XCNT(j)]); sum += c; cnt += (c > 0u) ? 1u : 0u; mine = (j == x) ? c : mine; }
        if (sum == G) break;
        __builtin_amdgcn_s_sleep(1);
        if ((++sp & 255u) == 0u) { if (xb_ld(&bar[XB_TMO])) break; if (sp > XB_SPIN_CAP) { atomicAdd(&bar[XB_TMO], 1u); break; } }
    }
    nloc = mine > 0u ? mine : 1u; nx = cnt > 0u ? cnt : 1u;
}

__device__ __forceinline__ void xcd_barrier(const XcdBarrier& b) {
    asm volatile("s_waitcnt vmcnt(0)" ::: "memory");
    __syncthreads();
    if (threadIdx.x == 0) {
        unsigned* bar = b.bar;
        __builtin_amdgcn_s_waitcnt(0);
        unsigned nloc = b.st[0], nx = b.st[1];
        if (nloc == 0u) { xcd_barrier_complete(bar, b.x, nloc, nx); b.st[0] = nloc; b.st[1] = nx; }
        const unsigned old = xb_add(&bar[XB_XSUB(b.x)], 1u);
        const unsigned gen = old / nloc;
        if (old + 1u == (gen + 1u) * nloc) {
            __builtin_amdgcn_fence(__ATOMIC_RELEASE, "agent");
            asm volatile("s_waitcnt vmcnt(0)" ::: "memory");
            const unsigned og = xb_add(&bar[XB_TOP], 1u);
            const unsigned tg = og / nx;
            if (og + 1u == (tg + 1u) * nx) xb_add(&bar[XB_TOPGEN], 1u);
            else XB_SPIN(xb_ld(&bar[XB_TOPGEN]) == tg, bar);
            __builtin_amdgcn_fence(__ATOMIC_ACQUIRE, "agent");
            xb_add(&bar[XB_XGEN(b.x)], 1u);
            asm volatile("s_waitcnt vmcnt(0)" ::: "memory");
        } else {
            XB_SPIN(xb_ld(&bar[XB_XGEN(b.x)]) == gen, bar);
            __builtin_amdgcn_fence(__ATOMIC_ACQUIRE, "agent");
            asm volatile("s_waitcnt vmcnt(0)" ::: "memory");
        }
    }
    __syncthreads();
}

enum { P_PRO = 0, P_PROJ, P_TOPK, P_ATTN, P_COMB, P_MERGE, P_WOUT, P_LN1, P_GU, P_DOWN, P_LN2, NPH };
struct Args { const float* in[12]; float* out; unsigned char* ws; int ph_lo, ph_hi, li, pad; };
typedef __attribute__((address_space(4))) const Args* KArgPtr;
__device__ __forceinline__ KArgPtr opaque_kernarg() {
#if defined(__HIP_DEVICE_COMPILE__)
    auto p = __builtin_amdgcn_kernarg_segment_ptr(); asm volatile("" : "+s"(p)); return (KArgPtr)p;
#else
    return nullptr;
#endif
}
#define PHASE_ARGS KArgPtr ap_ = opaque_kernarg(); unsigned char* ws = ap_->ws; unsigned* ctl = (unsigned*)(ws + WS_CTL); const float* x = ap_->in[0]; float* out = ap_->out; const bf16* proj = (const bf16*)(ws + WS_PROJ); (void)ctl; (void)x; (void)out; (void)proj
__global__ void __launch_bounds__(NWAVES * 64, 2) mega_kernel(Args args_unused) {
    extern __shared__ __attribute__((aligned(16))) unsigned char lds_raw[];
    LAS unsigned char* lds = (LAS unsigned char*)lds_raw;
    volatile LAS unsigned* MISC = (volatile LAS unsigned*)(lds + MISC_OFF);
    const int tid = threadIdx.x, lane = tid & 63, wave = __builtin_amdgcn_readfirstlane(tid >> 6);
    const int G = gridDim.x, bx = blockIdx.x; const int vcu = (G % 8 == 0) ? (bx % 8) * (G / 8) + bx / 8 : bx;
    for (int u = tid; u < (LDS_BYTES - LDSCTL_OFF) / 4; u += NWAVES * 64) ((LAS unsigned*)(lds + LDSCTL_OFF))[u] = 0u;
    __syncthreads();
    XcdBarrier bar; int lo, hi;
    { KArgPtr ap_ = opaque_kernarg(); bar = xcd_barrier_post((unsigned*)(ap_->ws + WS_CTL) + CW_BAR + ap_->li * XCD_BAR_WORDS, MISC + 8); lo = ap_->ph_lo; hi = ap_->ph_hi; }
    unsigned tacc = 0;
#define IN(k) (lo <= (k) && (k) < hi)
#define SEAM(k) do { if (IN(k) && IN((k) + 1)) xcd_barrier(bar); } while (0)
    using pg8::bf16_t;

    if (IN(P_PRO)) { PHASE_ARGS;
        ProArgs pa{x, ap_->in[1], ap_->in[2], ap_->in[3], ap_->in[4], ap_->in[7], ap_->in[8], ap_->in[9], ws};
        prologue_body(pa, lds + wave * 16384, vcu * NWAVES + wave, G * NWAVES, lane);
    }
    SEAM(P_PRO);
    if (IN(P_PROJ)) { PHASE_ARGS;
        pg8::Gemm g{(const bf16_t*)(ws + WS_XB), (const bf16_t*)(ws + WS_WT_IN), S_, NPROJ, DM}; pg8::StaticOrder S; S.init(S_, NPROJ, G, bx);
        pg8::EpiProj E{(bf16_t*)(ws + WS_PROJ), NPROJ, C_GA, C_IK};
        pg8::gemm_phase<pg8::EpiProj, pg8::StaticOrder, PG8_ALIGN, PG8_SP2>(lds, g, S, E);
        {
            ProArgs pa{x, ap_->in[1], ap_->in[2], ap_->in[3], ap_->in[4], ap_->in[7], ap_->in[8], ap_->in[9], ws};
            for (;;) {
                if (tid == 0) MISC[17] = atomicAdd(ctl + 64 + ap_->li, 1u);
                __syncthreads();
                const int u = __builtin_amdgcn_readfirstlane((int)MISC[17]);
                __syncthreads();
                if (u * 8 >= N_LATE_ITEMS) break;
                late_item(pa, u * 8 + wave, lds + wave * 16384, lane);
            }
        }
    }
    SEAM(P_PROJ);
    if (IN(P_TOPK)) { PHASE_ARGS; TSTART(1);
#if DBG_TOPK
        for (int t = S_ - 1 - bx; t >= 0; t -= G) naive_topk_query<NWAVES * 64>(t, proj, (int*)(ws + WS_SELIDX2), (int*)(ws + WS_SELCNT2), (float*)lds_raw);
        __syncthreads();
#endif
        for (;;) {
            if (tid == 0) MISC[17] = atomicAdd(ctl + 48 + ap_->li, 1u);
            __syncthreads();
            const int u = __builtin_amdgcn_readfirstlane((int)MISC[17]);
            if (u >= S_ / 16) break;
            tk::topk_block(S_ / 16 - 1 - u, proj, (unsigned*)(ws + WS_MASK), lds, tid, lane, wave, tacc);
        }
#if NAIVE_ATTN || DBG_ATTN || DBG_TOPK
        xcd_barrier(bar);
        for (int t = vcu * NWAVES + wave; t < S_; t += G * NWAVES) mask_to_list_wave(t, (const unsigned*)(ws + WS_MASK), (int*)(ws + WS_SELIDX), (int*)(ws + WS_SELCNT), lane);
#endif
#if DBG_TOPK
        for (int t = vcu * NWAVES + wave; t < S_; t += G * NWAVES) list_compare_wave(t, (const int*)(ws + WS_SELIDX), (const int*)(ws + WS_SELCNT), (const int*)(ws + WS_SELIDX2), (const int*)(ws + WS_SELCNT2), ctl + 16, lane);
#endif
        TSTOP(1, tacc);
#if DBG_TIME
        if (tid == 0) atomicAdd(ctl + 19, tacc >> 4);
#endif
    }
    SEAM(P_TOPK);
    if (IN(P_ATTN)) { PHASE_ARGS;
#if NAIVE_ATTN
        for (int t = S_ - 1 - bx; t >= 0; t -= G) naive_attn_a_wave(t, wave, proj, (const int*)(ws + WS_SELIDX), (const int*)(ws + WS_SELCNT), (bf16*)(ws + WS_OA), (float*)(lds_raw + wave * 4096), lane);
        for (int tp = bx; tp < S_ / 2; tp += G) naive_attn_b_wave(2 * tp + (wave >> 2), wave & 3, proj, (bf16*)(ws + WS_OB), (float*)(lds_raw + wave * 4096), lane);
#else
        for (;;) {
            if (tid == 0) MISC[17] = atomicAdd(ctl + 32 + ap_->li, 1u);
            __syncthreads();
            const int u = __builtin_amdgcn_readfirstlane((int)MISC[17]);
            if (u >= N_ATTN_UNITS) break;
            attn_run_unit(u, ws, (char*)lds_raw);
        }
#endif
    }
    SEAM(P_ATTN);
    if (IN(P_COMB)) { PHASE_ARGS;
#if !NAIVE_ATTN
        for (int t = vcu * NWAVES + wave; t < S_; t += G * NWAVES) combine_token(t, attn_bufs(ws), (bf16*)(ws + WS_OA), (bf16*)(ws + WS_OB), lane);
#if DBG_ATTN
        xcd_barrier(bar);
        for (int t = S_ - 1 - bx; t >= 0; t -= G) naive_attn_a_wave(t, wave, proj, (const int*)(ws + WS_SELIDX), (const int*)(ws + WS_SELCNT), (bf16*)(ws + WS_OA), (float*)(lds_raw + wave * 4096), lane, ctl + 17);
        for (int tp = bx; tp < S_ / 2; tp += G) naive_attn_b_wave(2 * tp + (wave >> 2), wave & 3, proj, (bf16*)(ws + WS_OB), (float*)(lds_raw + wave * 4096), lane, ctl + 18);
#endif
#endif
    }
    SEAM(P_COMB);
    if (IN(P_MERGE)) { PHASE_ARGS;
        { pg8::Gemm g{(const bf16_t*)(ws + WS_OA), (const bf16_t*)(ws + WS_WT_A), S_, DM, 1024}; pg8::StaticOrder S; S.init(S_, DM, G, bx);
          pg8::EpiMerge<1> E{(const bf16_t*)(ws + WS_PROJ), NPROJ, C_GA, out, DM, nullptr, 0};
          pg8::gemm_phase<pg8::EpiMerge<1>, pg8::StaticOrder, PG8_ALIGN, PG8_SP2>(lds, g, S, E); }
        { pg8::Gemm g{(const bf16_t*)(ws + WS_OB), (const bf16_t*)(ws + WS_WT_B), S_, DM, 512}; pg8::StaticOrder S; S.init(S_, DM, G, bx);
          pg8::EpiMerge<2> E{(const bf16_t*)(ws + WS_PROJ), NPROJ, C_GB, out, DM, (bf16_t*)(ws + WS_MERGED), DM};
          pg8::gemm_phase<pg8::EpiMerge<2>, pg8::StaticOrder, PG8_ALIGN, PG8_SP2>(lds, g, S, E); }
    }
    SEAM(P_MERGE);
    if (IN(P_WOUT)) { PHASE_ARGS;
        pg8::Gemm g{(const bf16_t*)(ws + WS_MERGED), (const bf16_t*)(ws + WS_WT_OUT), S_, DM, DM}; pg8::StaticOrder S; S.init(S_, DM, G, bx);
        pg8::EpiRes E{x, (float*)(ws + WS_H), DM, ALPHA};
        pg8::gemm_phase<pg8::EpiRes, pg8::StaticOrder, PG8_ALIGN, PG8_SP2>(lds, g, S, E);
    }
    SEAM(P_WOUT);
    if (IN(P_LN1)) { PHASE_ARGS; for (int row = vcu * NWAVES + wave; row < S_; row += G * NWAVES) ln_row((const float*)(ws + WS_H), ap_->in[5], ap_->in[6], (float*)(ws + WS_H), (bf16*)(ws + WS_HB), row, lane); }
    SEAM(P_LN1);
    if (IN(P_GU)) { PHASE_ARGS;
        pg8::Gemm g{(const bf16_t*)(ws + WS_HB), (const bf16_t*)(ws + WS_WT_GU), S_, NGU, DM}; pg8::StaticOrder S; S.init(S_, NGU, G, bx);
        pg8::EpiSwiGLU E{(bf16_t*)(ws + WS_ACT), DFF};
        pg8::gemm_phase<pg8::EpiSwiGLU, pg8::StaticOrder, PG8_ALIGN, PG8_SP2>(lds, g, S, E);
    }
    SEAM(P_GU);
    if (IN(P_DOWN)) { PHASE_ARGS;
        pg8::Gemm g{(const bf16_t*)(ws + WS_ACT), (const bf16_t*)(ws + WS_WT_DOWN), S_, DM, DFF}; pg8::StaticOrder S; S.init(S_, DM, G, bx);
        pg8::EpiRes E{(const float*)(ws + WS_H), out, DM, ALPHA};
        pg8::gemm_phase<pg8::EpiRes, pg8::StaticOrder, PG8_ALIGN, PG8_SP2>(lds, g, S, E);
    }
    SEAM(P_DOWN);
    if (IN(P_LN2)) { PHASE_ARGS; for (int row = vcu * NWAVES + wave; row < S_; row += G * NWAVES) ln_row(out, ap_->in[10], ap_->in[11], out, (bf16*)nullptr, row, lane); }
#if DBG_ANY
    if (IN(P_LN2) && vcu == 0 && tid == 0) { PHASE_ARGS;
        asm volatile("s_waitcnt vmcnt(0)" ::: "memory");
        const float cntf = (float)__hip_atomic_load(ctl + 16, __ATOMIC_RELAXED, __HIP_MEMORY_SCOPE_AGENT); const float mx = fmaxf(__uint_as_float(__hip_atomic_load(ctl + 17, __ATOMIC_RELAXED, __HIP_MEMORY_SCOPE_AGENT)), DBG_BSEL * __uint_as_float(__hip_atomic_load(ctl + 18, __ATOMIC_RELAXED, __HIP_MEMORY_SCOPE_AGENT)));
        float tus = 0.16f * (float)__hip_atomic_load(ctl + 19, __ATOMIC_RELAXED, __HIP_MEMORY_SCOPE_AGENT) / (float)G;
        if (tus > 0.f) tus = exp2f(rintf(4.f * log2f(tus)) * 0.25f);
        out[0] += 4096.f * sqrtf(cntf + mx + tus);
    }
#endif
#undef IN
#undef SEAM
}

#ifndef MK_RANGES
#define MK_RANGES {0, NPH}
#endif
extern "C" void kernel_launch(void* const* d_in, const int* in_sizes, int n_in, void* d_out, int out_size, void* d_ws, size_t ws_size, hipStream_t stream) {
    static int grid = 0;
    if (grid == 0) {
        if (n_in != 12 || in_sizes[0] != S_ * DM || out_size != S_ * DM || ws_size < WS_END) { fprintf(stderr, "kernel_launch: unexpected shapes / workspace (n_in %d, in0 %d, out %d, ws %zu)\n", n_in, n_in > 0 ? in_sizes[0] : -1, out_size, ws_size); grid = -1; return; }
        int dev = 0, cus = 0, per_cu = 0;
        if (hipGetDevice(&dev) != hipSuccess || hipDeviceGetAttribute(&cus, hipDeviceAttributeMultiprocessorCount, dev) != hipSuccess) { grid = -1; return; }
        if (hipFuncSetAttribute((const void*)mega_kernel, hipFuncAttributeMaxDynamicSharedMemorySize, LDS_BYTES) != hipSuccess) { fprintf(stderr, "kernel_launch: hipFuncSetAttribute failed\n"); grid = -1; return; }
        if (hipOccupancyMaxActiveBlocksPerMultiprocessor(&per_cu, (const void*)mega_kernel, NWAVES * 64, LDS_BYTES) != hipSuccess || per_cu < 1) { fprintf(stderr, "kernel_launch: occupancy query says %d workgroups per CU\n", per_cu); (void)hipGetLastError(); grid = -1; return; }
        grid = cus;
    }
    if (grid < 0) return;
    if (hipMemsetAsync((char*)d_ws + WS_CTL, 0, CTL_ZERO_BYTES, stream) != hipSuccess) return;
    Args a{};
    for (int i = 0; i < 12; ++i) a.in[i] = (const float*)d_in[i];
    a.out = (float*)d_out; a.ws = (unsigned char*)d_ws;
    const int rg[] = MK_RANGES; const int nl = (int)(sizeof(rg) / sizeof(int)) / 2;
    for (int li = 0; li < nl; ++li) { a.ph_lo = rg[2 * li]; a.ph_hi = rg[2 * li + 1]; a.li = li;
        hipLaunchKernelGGL(mega_kernel, dim3(grid), dim3(NWAVES * 64), LDS_BYTES, stream, a); }
}
```
